# Optimizing an MI355X kernel written in HIP

```python
import jax, jax.numpy as jnp
from jax import lax
import numpy as np

D_MODEL = 2048
BATCH = 4
SEQ = 4096
DEPTH = 1

N_ATTN_HEADS = 8
HEAD_DIM = 128
ATTN_WIDTH = N_ATTN_HEADS * HEAD_DIM
POOL_WINDOWS = (2, 4, 8, 16)
N_POOL_GROUPS = len(POOL_WINDOWS)
POOL_GROUP_WIDTH = 256
POOL_WIDTH = N_POOL_GROUPS * POOL_GROUP_WIDTH
N_BRANCHES = 2
IN_WIDTH = 3 * ATTN_WIDTH + POOL_WIDTH + N_BRANCHES * D_MODEL
D_FF = 5632
CONV_WIDTH = 3
PLE_DIM = 256
Q_BLOCK = 128
EPS = 1e-6

kernel_name = "hybrid_stickbreak_pool_convffn_layer"


def rmsnorm(x, gain):
    xf = x.astype(jnp.float32)
    y = xf * lax.rsqrt(jnp.mean(xf * xf, axis=-1, keepdims=True) + EPS)
    return (y * gain.astype(jnp.float32)).astype(x.dtype)


def stick_breaking_attention(q, k, v):
    B, S, H, Dh = q.shape
    nb = S // Q_BLOCK
    scale = Dh ** -0.5
    qb = q.reshape(B, nb, Q_BLOCK, H, Dh).transpose(1, 0, 3, 2, 4)
    starts = jnp.arange(nb, dtype=jnp.int32) * Q_BLOCK
    key_pos = jnp.arange(S, dtype=jnp.int32)

    def block(args):
        q_i, start = args
        z = jnp.einsum('bhqd,bkhd->bhqk', q_i, k).astype(jnp.float32) * scale
        q_pos = start + jnp.arange(Q_BLOCK, dtype=jnp.int32)
        causal = key_pos[None, :] < q_pos[:, None]
        log_1m_beta = jnp.where(causal, jax.nn.log_sigmoid(-z), 0.0)
        suffix = lax.cumsum(log_1m_beta, axis=3, reverse=True) - log_1m_beta
        log_a = jax.nn.log_sigmoid(z) + suffix
        a = jnp.where(causal, jnp.exp(log_a), 0.0)
        return jnp.einsum('bhqk,bkhd->bqhd', a.astype(v.dtype), v)

    out = lax.map(block, (qb, starts))
    return out.transpose(1, 0, 2, 3, 4).reshape(B, S, H * Dh)


def multiscale_causal_pool(u):
    B, S, _ = u.shape
    groups = u.astype(jnp.float32).reshape(B, S, N_POOL_GROUPS, POOL_GROUP_WIDTH)
    csum = jnp.pad(jnp.cumsum(groups, axis=1), ((0, 0), (1, 0), (0, 0), (0, 0)))
    pos = jnp.arange(S, dtype=jnp.int32)
    means = []
    for g, w in enumerate(POOL_WINDOWS):
        upper = csum[:, 1:, g]
        lower = jnp.pad(csum[:, :S + 1 - w, g], ((0, 0), (w - 1, 0), (0, 0)))
        count = jnp.minimum(pos + 1, w).astype(jnp.float32)[None, :, None]
        means.append((upper - lower) / count)
    return jnp.stack(means, axis=2) - groups


def causal_depthwise_conv(h, w, b):
    S = h.shape[1]
    hp = jnp.pad(h, ((0, 0), (CONV_WIDTH - 1, 0), (0, 0)))
    out = b
    for j in range(CONV_WIDTH):
        out = out + hp[:, j:j + S] * w[j]
    return out


def setup_inputs(seed: int = 0) -> dict:
    key = jax.random.key(seed)
    ks = jax.random.split(key, 20)
    f32 = jnp.float32

    def w(k, shape, fan_in):
        return jax.random.normal(k, shape, f32) * (fan_in ** -0.5)

    def gain(k, shape):
        return 1.0 + 0.02 * jax.random.normal(k, shape, f32)

    return {
        "x": jax.random.normal(ks[0], (BATCH, SEQ, D_MODEL), f32),
        "p": jax.random.normal(ks[1], (DEPTH, BATCH, SEQ, PLE_DIM), f32),
        "norm_mix_pre": gain(ks[2], (DEPTH, D_MODEL)),
        "w_in": w(ks[3], (DEPTH, D_MODEL, IN_WIDTH), D_MODEL),
        "w_attn_branch": w(ks[4], (DEPTH, ATTN_WIDTH, D_MODEL), ATTN_WIDTH),
        "w_pool_group": w(ks[5], (DEPTH, N_POOL_GROUPS, POOL_GROUP_WIDTH, POOL_GROUP_WIDTH), POOL_GROUP_WIDTH),
        "pool_scale": gain(ks[6], (DEPTH, POOL_WIDTH)),
        "w_pool_branch": w(ks[7], (DEPTH, POOL_WIDTH, D_MODEL), POOL_WIDTH),
        "w_out": w(ks[8], (DEPTH, D_MODEL, D_MODEL), D_MODEL),
        "norm_mix_post": gain(ks[9], (DEPTH, D_MODEL)),
        "norm_ffn_pre": gain(ks[10], (DEPTH, D_MODEL)),
        "w_up": w(ks[11], (DEPTH, D_MODEL, 2 * D_FF), D_MODEL),
        "conv_w": w(ks[12], (DEPTH, CONV_WIDTH, 2 * D_FF), CONV_WIDTH),
        "conv_b": 0.01 * jax.random.normal(ks[13], (DEPTH, 2 * D_FF), f32),
        "w_down": w(ks[14], (DEPTH, D_FF, D_MODEL), D_FF),
        "norm_ffn_post": gain(ks[15], (DEPTH, D_MODEL)),
        "w_ple": w(ks[16], (DEPTH, PLE_DIM, D_MODEL), PLE_DIM),
        "w_ple_gate": w(ks[17], (DEPTH, D_MODEL, D_MODEL), D_MODEL),
        "norm_ple_post": gain(ks[18], (DEPTH, D_MODEL)),
    }


def reference(x, p, norm_mix_pre, w_in, w_attn_branch, w_pool_group, pool_scale, w_pool_branch, w_out,
              norm_mix_post, norm_ffn_pre, w_up, conv_w, conv_b, w_down, norm_ffn_post, w_ple, w_ple_gate,
              norm_ple_post):
    B, S, _ = x.shape
    splits = [ATTN_WIDTH, 2 * ATTN_WIDTH, 3 * ATTN_WIDTH, 3 * ATTN_WIDTH + POOL_WIDTH,
              3 * ATTN_WIDTH + POOL_WIDTH + D_MODEL]
    for i in range(DEPTH):
        h = rmsnorm(x, norm_mix_pre[i])
        proj = h @ w_in[i]
        q, k, v, u, g_attn, g_pool = jnp.split(proj, splits, axis=-1)
        q = q.reshape(B, S, N_ATTN_HEADS, HEAD_DIM)
        k = k.reshape(B, S, N_ATTN_HEADS, HEAD_DIM)
        v = v.reshape(B, S, N_ATTN_HEADS, HEAD_DIM)
        y_attn = stick_breaking_attention(q, k, v) @ w_attn_branch[i]

        pooled = multiscale_causal_pool(u).astype(u.dtype)
        pooled = jnp.einsum('bsgc,gcd->bsgd', pooled, w_pool_group[i]).reshape(B, S, POOL_WIDTH)
        y_pool = (pooled * pool_scale[i]) @ w_pool_branch[i]

        mixed = jax.nn.sigmoid(g_attn) * y_attn + jax.nn.sigmoid(g_pool) * y_pool
        x = x + rmsnorm(mixed @ w_out[i], norm_mix_post[i])

        h = rmsnorm(x, norm_ffn_pre[i])
        up = causal_depthwise_conv(h @ w_up[i], conv_w[i], conv_b[i])
        gate, val = jnp.split(up, 2, axis=-1)
        y_ffn = (jax.nn.gelu(gate, approximate=True) * val) @ w_down[i]
        x = x + rmsnorm(y_ffn, norm_ffn_post[i])

        e = p[i] @ w_ple[i]
        x = x + rmsnorm(jax.nn.sigmoid(x @ w_ple_gate[i]) * e, norm_ple_post[i])
    return x
```

```cpp
#include <hip/hip_runtime.h>
#include <hip/hip_cooperative_groups.h>
#include <cstdio>
namespace cg = cooperative_groups;

#define LAS __attribute__((address_space(3)))
typedef unsigned short bf16_t;
typedef short bf16x8 __attribute__((ext_vector_type(8)));
typedef float f32x4 __attribute__((ext_vector_type(4)));
typedef float f32x16 __attribute__((ext_vector_type(16)));
typedef unsigned u32x4 __attribute__((ext_vector_type(4)));
typedef unsigned u32x2 __attribute__((ext_vector_type(2)));

constexpr int MTOK = 16384, DM = 2048, SEQ = 4096, AW = 1024, PW = 1024, DFF = 5632, UPW = 11264, PLE = 256;
constexpr float EPS = 1e-6f;
constexpr float LOG2E = 1.4426950408889634f;
constexpr size_t MiB = 1048576;
constexpr size_t WS_WIN = 0, WS_WAB = 32 * MiB, WS_WPG = 36 * MiB, WS_WPB = 37 * MiB, WS_WOUT = 41 * MiB, WS_WUP = 49 * MiB, WS_WDN = 93 * MiB, WS_WPLE = 115 * MiB, WS_WPGATE = 116 * MiB;
constexpr size_t WS_Q = 124 * MiB, WS_K = 156 * MiB, WS_U = 188 * MiB, WS_VT = 220 * MiB, WS_GA = 252 * MiB, WS_GP = 316 * MiB;
constexpr size_t WS_H = 380 * MiB, WS_AO = 380 * MiB, WS_P2 = 412 * MiB, WS_P1 = 444 * MiB, WS_PB = 476 * MiB;
constexpr size_t WS_MIXED = 124 * MiB, WS_TMP = 188 * MiB, WS_Y = 188 * MiB, WS_ACT = 124 * MiB, WS_HALO = 300 * MiB, WS_X2B = 124 * MiB, WS_E = 188 * MiB, WS_Z = 252 * MiB;

struct Params { const float* in[19]; float* out; unsigned char* ws; int ph_lo, ph_hi; };

__device__ __forceinline__ unsigned cvt_pk_bf16(float lo, float hi) { unsigned r; asm("v_cvt_pk_bf16_f32 %0, %1, %2" : "=v"(r) : "v"(lo), "v"(hi)); return r; }
__device__ __forceinline__ float bf_lo(unsigned w) { return __uint_as_float(w << 16); }
__device__ __forceinline__ float bf_hi(unsigned w) { return __uint_as_float(w & 0xffff0000u); }
__device__ __forceinline__ float sigmoidf_(float x) { return __builtin_amdgcn_rcpf(1.0f + __builtin_amdgcn_exp2f(-LOG2E * x)); }
__device__ __forceinline__ float wave_sum(float v) {
#pragma unroll
    for (int o = 32; o; o >>= 1) v += __shfl_xor(v, o);
    return v;
}
__device__ __forceinline__ float dpp_ror1(float x) { return __int_as_float(__builtin_amdgcn_update_dpp(0, __float_as_int(x), 0x121, 0xF, 0xF, false)); }
__device__ __forceinline__ float dpp_ror2(float x) { return __int_as_float(__builtin_amdgcn_update_dpp(0, __float_as_int(x), 0x122, 0xF, 0xF, false)); }
__device__ __forceinline__ f32x4 ror1v(f32x4 x) { return (f32x4){dpp_ror1(x[0]), dpp_ror1(x[1]), dpp_ror1(x[2]), dpp_ror1(x[3])}; }
__device__ __forceinline__ f32x4 ror2v(f32x4 x) { return (f32x4){dpp_ror2(x[0]), dpp_ror2(x[1]), dpp_ror2(x[2]), dpp_ror2(x[3])}; }
__device__ __forceinline__ float gelu_mul(float g, float v) {
    const float u = g * (0.7978845608f + 0.0356774081f * g * g);
    return g * v * __builtin_amdgcn_rcpf(1.0f + __builtin_amdgcn_exp2f(-2.0f * LOG2E * u));
}

constexpr int BM = 256, BK = 64, HALF = 128, HTB = HALF * BK * 2, STAGE_BYTES = 8 * HTB, NXCD = 8, WGM = 8;
__host__ __device__ __forceinline__ int lds_byte(int r, int c) { const int st = (r >> 4) * 2 + (c >> 5), rr = r & 15, cc = c & 31, ob = rr * 64 + cc * 2; return st * 1024 + (ob ^ (((ob >> 9) & 1) << 5)); }
__host__ __device__ __forceinline__ void stage_rc(int b, int& R, int& C) { const int st = b / 1024, sb = b % 1024, swz = sb ^ (((sb >> 9) & 1) << 5); R = (st >> 1) * 16 + swz / 64; C = (st & 1) * 32 + (swz % 64) / 2; }
__host__ __device__ __forceinline__ int perm32(int rho) { const int n = rho >> 4, i = rho & 15; return 8 * (i >> 2) + 4 * n + (i & 3); }

struct Unit { int pm, pn; };
struct Gemm { const bf16_t* A; const bf16_t* Bt; int M, N, K, lda, ldb; };
struct StaticOrder {
    int nM, nN, nwg, G, c;
    __device__ void init(int M, int N, int G_, int c_) { nM = M / BM; nN = N / BM; nwg = nM * nN; G = G_; c = c_; }
    __device__ bool next(int i, Unit& u) const {
        const long L = (long)i * G + c; if (L >= nwg) return false;
        int wgid = (int)L; { const int q = nwg / NXCD, r = nwg % NXCD, xcd = wgid % NXCD, off = wgid / NXCD; wgid = (xcd < r ? xcd * (q + 1) : r * (q + 1) + (xcd - r) * q) + off; }
        const int nig = WGM * nN, gid = wgid / nig, fm = gid * WGM, gsz = (nM - fm) < WGM ? (nM - fm) : WGM;
        u.pm = fm + ((wgid % nig) % gsz); u.pn = (wgid % nig) / gsz; return true;
    }
};

enum { EPI_PROJ = 0, EPI_PLAIN = 1, EPI_GATE1 = 2, EPI_GATE2 = 3, EPI_UP = 4, EPI_PLE = 5 };
template <int MODE> struct Epi {
    bf16_t* O; int ldc;
    const bf16_t* X1; const bf16_t* X2; int ldx;
    const float* cs; const float* cb; float* halo; unsigned char* ws; float qscale;
    __device__ __forceinline__ void operator()(const f32x4 (&acc)[2][2][4][2], const Unit& u, int wr, int wc, int fr, int fq) const {
        const int row0 = u.pm * BM + wr * 64 + fr;
        const int colb = u.pn * BM + wc * 32 + 8 * fq;
        if constexpr (MODE == EPI_UP) {
            const int ch0 = u.pn * 128 + wc * 32 + 8 * fq;
            const int blk0 = u.pm * 4 + wr;
            const bool sel1 = fr >= 1, sel2 = fr >= 2;
#pragma unroll
            for (int n = 0; n < 2; ++n) {
                const int ch = ch0 + 4 * n;
#pragma unroll
                for (int ai = 0; ai < 2; ++ai) {
                    f32x4 Gc[4];
                    float* hp = halo + (size_t)((blk0 + 2 * ai) * 4) * UPW + ch;
#pragma unroll
                    for (int bj = 0; bj < 2; ++bj) {
                        const int cc = bj * DFF + ch;
                        const f32x4 w0 = *(const f32x4*)(cs + cc), w1 = *(const f32x4*)(cs + UPW + cc), w2 = *(const f32x4*)(cs + 2 * UPW + cc), bb = *(const f32x4*)(cb + cc);
                        f32x4 P1 = (f32x4){0.f, 0.f, 0.f, 0.f}, P2 = P1;
#pragma unroll
                        for (int m = 0; m < 4; ++m) {
                            const f32x4 X = acc[ai][bj][m][n];
                            const f32x4 R1 = ror1v(X), R2 = ror2v(X);
                            f32x4 p1, p2;
#pragma unroll
                            for (int e = 0; e < 4; ++e) { p1[e] = sel1 ? R1[e] : P1[e]; p2[e] = sel2 ? R2[e] : P2[e]; }
                            const f32x4 cv = bb + w2 * X + w1 * p1 + w0 * p2;
                            P1 = R1; P2 = R2;
                            if (m == 0 && fr < 2) *(f32x4*)(hp + bj * DFF + (size_t)fr * UPW) = X;
                            if (m == 3 && fr >= 14) *(f32x4*)(hp + bj * DFF + (size_t)(fr - 12) * UPW) = X;
                            if (bj == 0) Gc[m] = cv;
                            else {
                                const f32x4 g = Gc[m];
                                u32x2 o; o[0] = cvt_pk_bf16(gelu_mul(g[0], cv[0]), gelu_mul(g[1], cv[1])); o[1] = cvt_pk_bf16(gelu_mul(g[2], cv[2]), gelu_mul(g[3], cv[3]));
                                *(u32x2*)(O + (size_t)(row0 + ai * HALF + m * 16) * DFF + ch) = o;
                            }
                        }
                    }
                }
            }
        } else {
            bf16_t* base = O; int ld = ldc, coff = 0; float sc = 1.0f;
            if constexpr (MODE == EPI_PROJ) {
                const int pn = u.pn;
                if (pn < 4) { base = (bf16_t*)(ws + WS_Q); ld = 1024; coff = 0; sc = qscale; }
                else if (pn < 8) { base = (bf16_t*)(ws + WS_K); ld = 1024; coff = 1024; }
                else if (pn < 12) { base = (bf16_t*)(ws + WS_U); ld = 1024; coff = 2048; }
                else if (pn < 20) { base = (bf16_t*)(ws + WS_GA); ld = 2048; coff = 3072; }
                else { base = (bf16_t*)(ws + WS_GP); ld = 2048; coff = 5120; }
            }
#pragma unroll
            for (int bj = 0; bj < 2; ++bj) {
                const int c = colb + bj * HALF;
                f32x4 cs0 = (f32x4){sc, sc, sc, sc}, cs1 = cs0;
                if constexpr (MODE == EPI_PLAIN) { if (cs) { cs0 = *(const f32x4*)(cs + c); cs1 = *(const f32x4*)(cs + c + 4); } }
#pragma unroll
                for (int ai = 0; ai < 2; ++ai)
#pragma unroll
                    for (int m = 0; m < 4; ++m) {
                        const int r = row0 + ai * HALF + m * 16;
                        f32x4 v0 = acc[ai][bj][m][0] * cs0, v1 = acc[ai][bj][m][1] * cs1;
                        if constexpr (MODE == EPI_GATE1 || MODE == EPI_GATE2) {
                            const u32x4 g = *(const u32x4*)(X1 + (size_t)r * ldx + c);
                            v0[0] *= sigmoidf_(bf_lo(g[0])); v0[1] *= sigmoidf_(bf_hi(g[0])); v0[2] *= sigmoidf_(bf_lo(g[1])); v0[3] *= sigmoidf_(bf_hi(g[1]));
                            v1[0] *= sigmoidf_(bf_lo(g[2])); v1[1] *= sigmoidf_(bf_hi(g[2])); v1[2] *= sigmoidf_(bf_lo(g[3])); v1[3] *= sigmoidf_(bf_hi(g[3]));
                            if constexpr (MODE == EPI_GATE2) {
                                const u32x4 t = *(const u32x4*)(X2 + (size_t)r * ldx + c);
                                v0[0] += bf_lo(t[0]); v0[1] += bf_hi(t[0]); v0[2] += bf_lo(t[1]); v0[3] += bf_hi(t[1]);
                                v1[0] += bf_lo(t[2]); v1[1] += bf_hi(t[2]); v1[2] += bf_lo(t[3]); v1[3] += bf_hi(t[3]);
                            }
                        }
                        if constexpr (MODE == EPI_PLE) {
                            const u32x4 e = *(const u32x4*)(X1 + (size_t)r * ldx + c);
                            v0[0] = sigmoidf_(v0[0]) * bf_lo(e[0]); v0[1] = sigmoidf_(v0[1]) * bf_hi(e[0]); v0[2] = sigmoidf_(v0[2]) * bf_lo(e[1]); v0[3] = sigmoidf_(v0[3]) * bf_hi(e[1]);
                            v1[0] = sigmoidf_(v1[0]) * bf_lo(e[2]); v1[1] = sigmoidf_(v1[1]) * bf_hi(e[2]); v1[2] = sigmoidf_(v1[2]) * bf_lo(e[3]); v1[3] = sigmoidf_(v1[3]) * bf_hi(e[3]);
                        }
                        u32x4 o; o[0] = cvt_pk_bf16(v0[0], v0[1]); o[1] = cvt_pk_bf16(v0[2], v0[3]); o[2] = cvt_pk_bf16(v1[0], v1[1]); o[3] = cvt_pk_bf16(v1[2], v1[3]);
                        *(u32x4*)(base + (size_t)r * ld + (c - coff)) = o;
                    }
            }
        }
    }
};

template <class EpiT>
__device__ __forceinline__ void gemm_phase(LAS unsigned char* lds, const Gemm g, const StaticOrder& S, const EpiT& E) {
    const int tid = threadIdx.x, wid = __builtin_amdgcn_readfirstlane(tid >> 6), lane = tid & 63, wr = wid >> 2, wc = wid & 3, fr = lane & 15, fq = lane >> 4;
    const int K = g.K, nt = K / BK;
    unsigned voffA[2], voffB[2];
#pragma unroll
    for (int i = 0; i < 2; ++i) { int R, C; stage_rc(tid * 16 + i * 8192, R, C); const int Rb = (R & ~31) + perm32(R & 31);
        voffA[i] = (unsigned)(R * g.lda + C) * 2u; voffB[i] = (unsigned)(Rb * g.ldb + C) * 2u; }
    const size_t kstep = (size_t)(BK * 2);
    const size_t hstepA = (size_t)HALF * g.lda * 2, hstepB = (size_t)HALF * g.ldb * 2;
    const size_t tstepA = 2 * hstepA, tstepB = 2 * hstepB;
    const unsigned ldsw = (unsigned)wid * 1024u;
    const int aoff = lds_byte(wr * 64 + fr, fq * 8), boff = lds_byte(wc * 32 + fr, fq * 8);
#define PG8_SA(b, h) (((b) * 2 + (h)) * HTB)
#define PG8_SB(b, h) ((4 + (b) * 2 + (h)) * HTB)
#define PG8_STAGE(bufoff, gbase, voff) do { _Pragma("unroll") for (int _i = 0; _i < 2; ++_i) \
        __builtin_amdgcn_global_load_lds((const unsigned*)((const char*)(gbase) + (voff)[_i]), (LAS unsigned*)(lds + (bufoff) + ldsw + _i * 8192), 16, 0, 0); } while (0)
#define PG8_LDA(dst, b, h) do { _Pragma("unroll") for (int m = 0; m < 4; ++m) _Pragma("unroll") for (int k = 0; k < 2; ++k) dst[m][k] = *(const LAS bf16x8*)(lds + PG8_SA(b, h) + aoff + m * 2048 + k * 1024); } while (0)
#define PG8_LDB(dst, b, h) do { _Pragma("unroll") for (int n = 0; n < 2; ++n) _Pragma("unroll") for (int k = 0; k < 2; ++k) dst[n][k] = *(const LAS bf16x8*)(lds + PG8_SB(b, h) + boff + n * 2048 + k * 1024); } while (0)
#define PG8_MMA(ai, bj, At, Bt) do { __builtin_amdgcn_s_setprio(1); _Pragma("unroll") for (int m = 0; m < 4; ++m) _Pragma("unroll") for (int n = 0; n < 2; ++n) _Pragma("unroll") for (int k = 0; k < 2; ++k) \
        acc[ai][bj][m][n] = __builtin_amdgcn_mfma_f32_16x16x32_bf16(Bt[n][k], At[m][k], acc[ai][bj][m][n], 0, 0, 0); __builtin_amdgcn_s_setprio(0); } while (0)
#define PG8_WAIT_V(n) asm volatile("s_waitcnt vmcnt(" #n ")" ::: "memory")
#define PG8_WAIT_L(n) asm volatile("s_waitcnt lgkmcnt(" #n ")" ::: "memory")
#define PG8_BAR __builtin_amdgcn_s_barrier()
#define PG8_SCHED __builtin_amdgcn_sched_barrier(0)
    Unit cur, nxt; int ui = 0;
    if (!S.next(0, cur)) return;
    f32x4 acc[2][2][4][2];
#pragma unroll
    for (int a = 0; a < 2; ++a)
#pragma unroll
        for (int b = 0; b < 2; ++b)
#pragma unroll
            for (int m = 0; m < 4; ++m)
#pragma unroll
                for (int n = 0; n < 2; ++n) acc[a][b][m][n] = (f32x4){0.f, 0.f, 0.f, 0.f};
    bf16x8 At[4][2], B0[2][2], B1[2][2];
    const char* cA = (const char*)g.A + (size_t)cur.pm * tstepA; const char* cB = (const char*)g.Bt + (size_t)cur.pn * tstepB;
    PG8_STAGE(PG8_SB(0, 0), cB, voffB); PG8_STAGE(PG8_SA(0, 0), cA, voffA); PG8_STAGE(PG8_SB(0, 1), cB + hstepB, voffB); PG8_STAGE(PG8_SA(0, 1), cA + hstepA, voffA);
    if (wr == 1) PG8_BAR;
    PG8_WAIT_V(4); PG8_BAR;
    PG8_STAGE(PG8_SB(1, 0), cB + kstep, voffB); PG8_STAGE(PG8_SA(1, 0), cA + kstep, voffA); PG8_STAGE(PG8_SB(1, 1), cB + hstepB + kstep, voffB);
    PG8_WAIT_V(6); PG8_BAR;
    for (;;) {
        const bool has_next = S.next(ui + 1, nxt);
        const char* nA = has_next ? (const char*)g.A + (size_t)nxt.pm * tstepA : cA; const char* nB = has_next ? (const char*)g.Bt + (size_t)nxt.pn * tstepB : cB;
        for (int t = 0; t < nt; t += 2) {
            const bool last = (t == nt - 2);
            const char* a1 = cA + (size_t)(t + 1) * kstep;
            const char* a2 = last ? nA : cA + (size_t)(t + 2) * kstep; const char* b2 = last ? nB : cB + (size_t)(t + 2) * kstep;
            const char* a3 = a2 + kstep; const char* b3 = b2 + kstep;
            PG8_LDB(B0, 0, 0); PG8_SCHED; PG8_LDA(At, 0, 0); PG8_STAGE(PG8_SA(1, 1), a1 + hstepA, voffA);
            PG8_WAIT_L(8); PG8_BAR; PG8_WAIT_L(0); PG8_MMA(0, 0, At, B0); PG8_BAR; PG8_SCHED;
            PG8_LDB(B1, 0, 1); PG8_STAGE(PG8_SB(0, 0), b2, voffB);
            PG8_BAR; PG8_WAIT_L(0); PG8_MMA(0, 1, At, B1); PG8_BAR;
            PG8_LDA(At, 0, 1); PG8_STAGE(PG8_SA(0, 0), a2, voffA);
            PG8_BAR; PG8_WAIT_L(0); PG8_MMA(1, 0, At, B0); PG8_BAR; PG8_SCHED;
            PG8_STAGE(PG8_SB(0, 1), b2 + hstepB, voffB);
            PG8_WAIT_V(6); PG8_BAR; PG8_MMA(1, 1, At, B1); PG8_BAR;
            PG8_LDB(B0, 1, 0); PG8_SCHED; PG8_LDA(At, 1, 0); PG8_STAGE(PG8_SA(0, 1), a2 + hstepA, voffA);
            PG8_WAIT_L(8); PG8_BAR; PG8_WAIT_L(0); PG8_MMA(0, 0, At, B0); PG8_BAR; PG8_SCHED;
            PG8_LDB(B1, 1, 1); PG8_STAGE(PG8_SB(1, 0), b3, voffB);
            PG8_BAR; PG8_WAIT_L(0); PG8_MMA(0, 1, At, B1); PG8_BAR;
            PG8_LDA(At, 1, 1); PG8_STAGE(PG8_SA(1, 0), a3, voffA);
            PG8_BAR; PG8_WAIT_L(0); PG8_MMA(1, 0, At, B0); PG8_BAR; PG8_SCHED;
            PG8_STAGE(PG8_SB(1, 1), b3 + hstepB, voffB);
            PG8_WAIT_V(6); PG8_BAR; PG8_MMA(1, 1, At, B1); PG8_BAR;
        }
        E(acc, cur, wr, wc, fr, fq);
        if (!has_next) break;
#pragma unroll
        for (int a = 0; a < 2; ++a)
#pragma unroll
            for (int b = 0; b < 2; ++b)
#pragma unroll
                for (int m = 0; m < 4; ++m)
#pragma unroll
                    for (int n = 0; n < 2; ++n) acc[a][b][m][n] = (f32x4){0.f, 0.f, 0.f, 0.f};
        cur = nxt; cA = nA; cB = nB; ++ui;
    }
    PG8_WAIT_V(0);
    if (wr == 0) PG8_BAR;
    PG8_BAR;
#undef PG8_SA
#undef PG8_SB
#undef PG8_STAGE
#undef PG8_LDA
#undef PG8_LDB
#undef PG8_MMA
#undef PG8_WAIT_V
#undef PG8_WAIT_L
#undef PG8_BAR
#undef PG8_SCHED
}

template <int MODE>
__device__ __forceinline__ void run_gemm(LAS unsigned char* lds, const bf16_t* A, int lda, const bf16_t* Bt, int ldb, int M, int N, int K, const Epi<MODE>& E, int crot = 0) {
    Gemm g; g.A = A; g.Bt = Bt; g.M = M; g.N = N; g.K = K; g.lda = lda; g.ldb = ldb;
    StaticOrder S; S.init(M, N, (int)gridDim.x, (int)((blockIdx.x + gridDim.x - crot) % gridDim.x));
    gemm_phase(lds, g, S, E);
}

__device__ __forceinline__ void cvt_transpose(const float* __restrict__ W, bf16_t* __restrict__ Wt, int K, int N, int ldt, int mode, float* tile) {
    const int tid = threadIdx.x, ntn = N / 64, ntk = K / 64, ntile = ntn * ntk;
    for (int t = blockIdx.x; t < ntile; t += gridDim.x) {
        const int tk = t / ntn, tn = t % ntn;
#pragma unroll
        for (int i = 0; i < 2; ++i) {
            const int idx = tid + i * 512, kk = idx >> 4, n4 = (idx & 15) * 4;
            const float4 v = *(const float4*)(W + (size_t)(tk * 64 + kk) * N + tn * 64 + n4);
            tile[(n4 + 0) * 65 + kk] = v.x; tile[(n4 + 1) * 65 + kk] = v.y; tile[(n4 + 2) * 65 + kk] = v.z; tile[(n4 + 3) * 65 + kk] = v.w;
        }
        __syncthreads();
        {
            const int n = tid >> 3, k8 = (tid & 7) * 8;
            int n0 = tn * 64;
            if (mode == 1) { n0 = n0 < 2048 ? n0 : (n0 < 3072 ? n0 + 5120 : n0 - 1024); }
            else if (mode == 2) { const int bj = n0 >= DFF ? 1 : 0, ch = n0 - bj * DFF; n0 = 256 * (ch >> 7) + 128 * bj + (ch & 127); }
            const float* tp = tile + n * 65 + k8;
            u32x4 o; o[0] = cvt_pk_bf16(tp[0], tp[1]); o[1] = cvt_pk_bf16(tp[2], tp[3]); o[2] = cvt_pk_bf16(tp[4], tp[5]); o[3] = cvt_pk_bf16(tp[6], tp[7]);
            *(u32x4*)(Wt + (size_t)(n0 + n) * ldt + tk * 64 + k8) = o;
        }
        __syncthreads();
    }
}

__device__ __forceinline__ void row_pass(const bf16_t* __restrict__ y, const float* xin, const float* __restrict__ g1, float* xo, const float* __restrict__ g2, bf16_t* __restrict__ hb, int hmode) {
    const int lane = threadIdx.x & 63, gw = blockIdx.x * 8 + (threadIdx.x >> 6), nw = gridDim.x * 8;
    for (int row = gw; row < MTOK; row += nw) {
        const float4* xr = (const float4*)(xin + (size_t)row * DM);
        float4 v[8];
#pragma unroll
        for (int i = 0; i < 8; ++i) v[i] = xr[lane + 64 * i];
        if (y) {
            const u32x2* yr = (const u32x2*)(y + (size_t)row * DM);
            float4 yv[8]; float ss = 0.f;
#pragma unroll
            for (int i = 0; i < 8; ++i) { const u32x2 w = yr[lane + 64 * i]; yv[i] = make_float4(bf_lo(w[0]), bf_hi(w[0]), bf_lo(w[1]), bf_hi(w[1])); ss += yv[i].x * yv[i].x + yv[i].y * yv[i].y + yv[i].z * yv[i].z + yv[i].w * yv[i].w; }
            ss = wave_sum(ss);
            const float rs = rsqrtf(ss * (1.0f / DM) + EPS);
#pragma unroll
            for (int i = 0; i < 8; ++i) { const float4 gg = ((const float4*)g1)[lane + 64 * i];
                v[i].x += yv[i].x * rs * gg.x; v[i].y += yv[i].y * rs * gg.y; v[i].z += yv[i].z * rs * gg.z; v[i].w += yv[i].w * rs * gg.w;
                ((float4*)(xo + (size_t)row * DM))[lane + 64 * i] = v[i]; }
        }
        if (hmode == 1) {
            float ss = 0.f;
#pragma unroll
            for (int i = 0; i < 8; ++i) ss += v[i].x * v[i].x + v[i].y * v[i].y + v[i].z * v[i].z + v[i].w * v[i].w;
            ss = wave_sum(ss);
            const float rs = rsqrtf(ss * (1.0f / DM) + EPS);
#pragma unroll
            for (int i = 0; i < 8; ++i) { const float4 gg = ((const float4*)g2)[lane + 64 * i];
                u32x2 o; o[0] = cvt_pk_bf16(v[i].x * rs * gg.x, v[i].y * rs * gg.y); o[1] = cvt_pk_bf16(v[i].z * rs * gg.z, v[i].w * rs * gg.w);
                ((u32x2*)(hb + (size_t)row * DM))[lane + 64 * i] = o; }
        } else if (hmode == 2) {
#pragma unroll
            for (int i = 0; i < 8; ++i) { u32x2 o; o[0] = cvt_pk_bf16(v[i].x, v[i].y); o[1] = cvt_pk_bf16(v[i].z, v[i].w); ((u32x2*)(hb + (size_t)row * DM))[lane + 64 * i] = o; }
        }
    }
}

__device__ __forceinline__ void pool_pass(const bf16_t* __restrict__ U, bf16_t* __restrict__ P1) {
    const int nthr = gridDim.x * 512;
    for (int it = blockIdx.x * 512 + threadIdx.x; it < MTOK * 128; it += nthr) {
        const int tok = it >> 7, c8 = (it & 127) * 8, grp = c8 >> 8, w = 2 << grp, tl = tok & (SEQ - 1);
        const int cnt = (tl + 1) < w ? (tl + 1) : w;
        float s[8] = {0.f, 0.f, 0.f, 0.f, 0.f, 0.f, 0.f, 0.f}, u0[8];
        for (int j = 0; j < cnt; ++j) {
            const u32x4 v = *(const u32x4*)(U + (size_t)(tok - j) * PW + c8);
            const float f[8] = {bf_lo(v[0]), bf_hi(v[0]), bf_lo(v[1]), bf_hi(v[1]), bf_lo(v[2]), bf_hi(v[2]), bf_lo(v[3]), bf_hi(v[3])};
#pragma unroll
            for (int e = 0; e < 8; ++e) { s[e] += f[e]; if (j == 0) u0[e] = f[e]; }
        }
        const float inv = 1.0f / (float)cnt;
        u32x4 o;
        o[0] = cvt_pk_bf16(s[0] * inv - u0[0], s[1] * inv - u0[1]); o[1] = cvt_pk_bf16(s[2] * inv - u0[2], s[3] * inv - u0[3]);
        o[2] = cvt_pk_bf16(s[4] * inv - u0[4], s[5] * inv - u0[5]); o[3] = cvt_pk_bf16(s[6] * inv - u0[6], s[7] * inv - u0[7]);
        *(u32x4*)(P1 + (size_t)tok * PW + c8) = o;
    }
}

__device__ __forceinline__ void conv_fixup(const float* __restrict__ halo, const float* __restrict__ cw, const float* __restrict__ cb, bf16_t* __restrict__ act) {
    const int nthr = gridDim.x * 512, nq = DFF / 4;
    for (int it = blockIdx.x * 512 + threadIdx.x; it < 512 * nq; it += nthr) {
        const int ri = it / nq, ch = (it % nq) * 4, blk = ri >> 1, i = ri & 1;
        const bool first = (blk & 63) == 0;
        f32x4 res[2];
#pragma unroll
        for (int bj = 0; bj < 2; ++bj) {
            const int cc = bj * DFF + ch;
            const f32x4 z = (f32x4){0.f, 0.f, 0.f, 0.f};
            const f32x4 cur = *(const f32x4*)(halo + (size_t)(blk * 4 + i) * UPW + cc);
            f32x4 p1, p2;
            if (i == 0) { p1 = first ? z : *(const f32x4*)(halo + (size_t)((blk - 1) * 4 + 3) * UPW + cc); p2 = first ? z : *(const f32x4*)(halo + (size_t)((blk - 1) * 4 + 2) * UPW + cc); }
            else { p1 = *(const f32x4*)(halo + (size_t)(blk * 4 + 0) * UPW + cc); p2 = first ? z : *(const f32x4*)(halo + (size_t)((blk - 1) * 4 + 3) * UPW + cc); }
            res[bj] = *(const f32x4*)(cb + cc) + *(const f32x4*)(cw + 2 * UPW + cc) * cur + *(const f32x4*)(cw + UPW + cc) * p1 + *(const f32x4*)(cw + cc) * p2;
        }
        u32x2 o; o[0] = cvt_pk_bf16(gelu_mul(res[0][0], res[1][0]), gelu_mul(res[0][1], res[1][1])); o[1] = cvt_pk_bf16(gelu_mul(res[0][2], res[1][2]), gelu_mul(res[0][3], res[1][3]));
        *(u32x2*)(act + (size_t)(blk * 64 + i) * DFF + ch) = o;
    }
}

__device__ __forceinline__ void k_load(bf16x8 (&k)[8], const bf16_t* kbase, int kt) {
    const bf16_t* kp = kbase + (size_t)kt * 32 * AW;
#pragma unroll
    for (int kk = 0; kk < 8; ++kk) k[kk] = *(const bf16x8*)(kp + 16 * kk);
}
__device__ __forceinline__ void v_load(bf16x8 (&v)[8], const bf16_t* vbase, int kt) {
    const bf16_t* vp = vbase + kt * 32;
#pragma unroll
    for (int d = 0; d < 4; ++d)
#pragma unroll
        for (int s = 0; s < 2; ++s) v[d * 2 + s] = *(const bf16x8*)(vp + (size_t)d * 32 * MTOK + 16 * s);
}
__device__ __forceinline__ void attn_item(const bf16_t* __restrict__ Q, const bf16_t* __restrict__ Kp, const bf16_t* __restrict__ Vt, bf16_t* __restrict__ AO, int b, int hd, int qblk, int lane) {
    const int r = lane & 31, h = lane >> 5;
    const int pr = (r & ~12) | ((r & 4) << 1) | ((r & 8) >> 1);
    const size_t tok0 = (size_t)b * SEQ + (size_t)qblk * 32;
    bf16x8 qf[8];
    const bf16_t* qp = Q + (tok0 + r) * AW + hd * 128 + 8 * h;
#pragma unroll
    for (int kk = 0; kk < 8; ++kk) qf[kk] = *(const bf16x8*)(qp + 16 * kk);
    f32x16 o[4];
#pragma unroll
    for (int d = 0; d < 4; ++d)
#pragma unroll
        for (int i = 0; i < 16; ++i) o[d][i] = 0.f;
    float carry = 0.f;
    const bf16_t* kbase = Kp + ((size_t)b * SEQ + pr) * AW + hd * 128 + 8 * h;
    const bf16_t* vbase = Vt + (size_t)(hd * 128 + r) * MTOK + (size_t)b * SEQ + 8 * h;
    bf16x8 kf[8], vf[8];
    k_load(kf, kbase, qblk);
    for (int kt = qblk; kt >= 0; --kt) {
        const bool diag = (kt == qblk);
        v_load(vf, vbase, kt);
        f32x16 s;
#pragma unroll
        for (int i = 0; i < 16; ++i) s[i] = 0.f;
#pragma unroll
        for (int kk = 0; kk < 8; ++kk) s = __builtin_amdgcn_mfma_f32_32x32x16_bf16(kf[kk], qf[kk], s, 0, 0, 0);
        if (kt > 0) k_load(kf, kbase, kt - 1);
        float T0 = 0.f, T1 = 0.f;
        float lm[16];
#pragma unroll
        for (int i = 0; i < 16; ++i) {
            const float y = s[i];
            const float e = __builtin_amdgcn_exp2f(-__builtin_fabsf(y));
            const float tt = __builtin_amdgcn_logf(1.0f + e);
            float lsv = fminf(y, 0.f) - tt;
            float lmv = lsv - y;
            if (diag) { const bool valid = (16 * (i >> 3) + 8 * h + (i & 7)) < r; lmv = valid ? lmv : 0.f; lsv = valid ? lsv : -1e30f; }
            s[i] = lsv; lm[i] = lmv;
            if (i < 8) T0 += lmv; else T1 += lmv;
        }
        const float OT0 = __shfl_xor(T0, 32), OT1 = __shfl_xor(T1, 32);
        const float after0 = (h == 0 ? OT0 : 0.f) + T1 + OT1, after1 = (h == 0 ? OT1 : 0.f);
        {
            float run = after0 + carry;
#pragma unroll
            for (int j = 7; j >= 0; --j) { s[j] = __builtin_amdgcn_exp2f(s[j] + run); run += lm[j]; }
            run = after1 + carry;
#pragma unroll
            for (int j = 7; j >= 0; --j) { s[8 + j] = __builtin_amdgcn_exp2f(s[8 + j] + run); run += lm[8 + j]; }
        }
        carry += (T0 + T1) + (OT0 + OT1);
        bf16x8 pf[2];
#pragma unroll
        for (int sI = 0; sI < 2; ++sI) {
            u32x4 w; w[0] = cvt_pk_bf16(s[8 * sI + 0], s[8 * sI + 1]); w[1] = cvt_pk_bf16(s[8 * sI + 2], s[8 * sI + 3]); w[2] = cvt_pk_bf16(s[8 * sI + 4], s[8 * sI + 5]); w[3] = cvt_pk_bf16(s[8 * sI + 6], s[8 * sI + 7]);
            pf[sI] = __builtin_bit_cast(bf16x8, w);
        }
#pragma unroll
        for (int d = 0; d < 4; ++d)
#pragma unroll
            for (int sI = 0; sI < 2; ++sI) o[d] = __builtin_amdgcn_mfma_f32_32x32x16_bf16(vf[d * 2 + sI], pf[sI], o[d], 0, 0, 0);
    }
    bf16_t* op = AO + (tok0 + r) * AW + hd * 128 + 4 * h;
#pragma unroll
    for (int d = 0; d < 4; ++d)
#pragma unroll
        for (int j = 0; j < 4; ++j) { u32x2 w; w[0] = cvt_pk_bf16(o[d][4 * j + 0], o[d][4 * j + 1]); w[1] = cvt_pk_bf16(o[d][4 * j + 2], o[d][4 * j + 3]); *(u32x2*)(op + d * 32 + 8 * j) = w; }
}
__device__ __forceinline__ void attn_phase(const bf16_t* Q, const bf16_t* Kp, const bf16_t* Vt, bf16_t* AO) {
    const int lane = threadIdx.x & 63, w = threadIdx.x >> 6;
    for (int g = blockIdx.x; g < 256; g += gridDim.x) {
        const int xcd = g & 7, idx = g >> 3, bh = xcd * 4 + (idx >> 3), sub = idx & 7, x = sub * 8 + w;
        const int b = bh >> 3, hd = bh & 7;
        attn_item(Q, Kp, Vt, AO, b, hd, 127 - x, lane);
        attn_item(Q, Kp, Vt, AO, b, hd, x, lane);
    }
}

#ifndef N_LAUNCH_MODE
#define N_LAUNCH_MODE 0
#endif
constexpr int NPHASE = 13;
template <int ph> __device__ __forceinline__ void run_phase(const Params& p, unsigned char* shm) {
    LAS unsigned char* lds = (LAS unsigned char*)shm;
    unsigned char* ws = p.ws;
    {
        if constexpr (ph == 0) {
            float* tile = (float*)shm;
            cvt_transpose(p.in[3], (bf16_t*)(ws + WS_WIN), DM, 8192, DM, 1, tile);
            cvt_transpose(p.in[4], (bf16_t*)(ws + WS_WAB), AW, DM, AW, 0, tile);
            cvt_transpose(p.in[5], (bf16_t*)(ws + WS_WPG), 1024, 256, 1024, 0, tile);
            cvt_transpose(p.in[7], (bf16_t*)(ws + WS_WPB), PW, DM, PW, 0, tile);
            cvt_transpose(p.in[8], (bf16_t*)(ws + WS_WOUT), DM, DM, DM, 0, tile);
            cvt_transpose(p.in[11], (bf16_t*)(ws + WS_WUP), DM, UPW, DM, 2, tile);
            cvt_transpose(p.in[14], (bf16_t*)(ws + WS_WDN), DFF, DM, DFF, 0, tile);
            cvt_transpose(p.in[16], (bf16_t*)(ws + WS_WPLE), PLE, DM, PLE, 0, tile);
            cvt_transpose(p.in[17], (bf16_t*)(ws + WS_WPGATE), DM, DM, DM, 0, tile);
            row_pass(nullptr, p.in[0], nullptr, nullptr, p.in[2], (bf16_t*)(ws + WS_H), 1);
            {
                const float4* src = (const float4*)p.in[1]; u32x2* dst = (u32x2*)(ws + WS_PB);
                for (int i = blockIdx.x * 512 + threadIdx.x; i < MTOK * PLE / 4; i += gridDim.x * 512) { const float4 v = src[i]; u32x2 o; o[0] = cvt_pk_bf16(v.x, v.y); o[1] = cvt_pk_bf16(v.z, v.w); dst[i] = o; }
            }
        } else if constexpr (ph == 1) {
            Epi<EPI_PROJ> e{}; e.ws = ws; e.qscale = 0.08838834764831845f * LOG2E;
            run_gemm(lds, (const bf16_t*)(ws + WS_H), DM, (const bf16_t*)(ws + WS_WIN), DM, MTOK, 7168, DM, e);
            Epi<EPI_PLAIN> ev{}; ev.O = (bf16_t*)(ws + WS_VT); ev.ldc = MTOK; ev.cs = nullptr;
            run_gemm(lds, (const bf16_t*)(ws + WS_WIN) + (size_t)7168 * DM, DM, (const bf16_t*)(ws + WS_H), DM, AW, MTOK, DM, ev);
        } else if constexpr (ph == 2) {
            pool_pass((const bf16_t*)(ws + WS_U), (bf16_t*)(ws + WS_P1));
            attn_phase((const bf16_t*)(ws + WS_Q), (const bf16_t*)(ws + WS_K), (const bf16_t*)(ws + WS_VT), (bf16_t*)(ws + WS_AO));
        } else if constexpr (ph == 3) {
            Epi<EPI_GATE1> e{}; e.O = (bf16_t*)(ws + WS_TMP); e.ldc = DM; e.X1 = (const bf16_t*)(ws + WS_GA); e.ldx = DM;
            run_gemm(lds, (const bf16_t*)(ws + WS_AO), AW, (const bf16_t*)(ws + WS_WAB), AW, MTOK, DM, AW, e);
            for (int gi = 0; gi < 4; ++gi) {
                Epi<EPI_PLAIN> eg{}; eg.O = (bf16_t*)(ws + WS_P2) + gi * 256; eg.ldc = PW; eg.cs = p.in[6] + gi * 256;
                run_gemm(lds, (const bf16_t*)(ws + WS_P1) + gi * 256, PW, (const bf16_t*)(ws + WS_WPG) + gi * 256, 1024, MTOK, 256, 256, eg, gi * 64);
            }
        } else if constexpr (ph == 4) {
            Epi<EPI_GATE2> e{}; e.O = (bf16_t*)(ws + WS_MIXED); e.ldc = DM; e.X1 = (const bf16_t*)(ws + WS_GP); e.X2 = (const bf16_t*)(ws + WS_TMP); e.ldx = DM;
            run_gemm(lds, (const bf16_t*)(ws + WS_P2), PW, (const bf16_t*)(ws + WS_WPB), PW, MTOK, DM, PW, e);
        } else if constexpr (ph == 5) {
            Epi<EPI_PLAIN> e{}; e.O = (bf16_t*)(ws + WS_Y); e.ldc = DM; e.cs = nullptr;
            run_gemm(lds, (const bf16_t*)(ws + WS_MIXED), DM, (const bf16_t*)(ws + WS_WOUT), DM, MTOK, DM, DM, e);
        } else if constexpr (ph == 6) {
            row_pass((const bf16_t*)(ws + WS_Y), p.in[0], p.in[9], p.out, p.in[10], (bf16_t*)(ws + WS_H), 1);
        } else if constexpr (ph == 7) {
            Epi<EPI_UP> e{}; e.O = (bf16_t*)(ws + WS_ACT); e.cs = p.in[12]; e.cb = p.in[13]; e.halo = (float*)(ws + WS_HALO);
            run_gemm(lds, (const bf16_t*)(ws + WS_H), DM, (const bf16_t*)(ws + WS_WUP), DM, MTOK, UPW, DM, e);
        } else if constexpr (ph == 8) {
            conv_fixup((const float*)(ws + WS_HALO), p.in[12], p.in[13], (bf16_t*)(ws + WS_ACT));
        } else if constexpr (ph == 9) {
            Epi<EPI_PLAIN> e{}; e.O = (bf16_t*)(ws + WS_H); e.ldc = DM; e.cs = nullptr;
            run_gemm(lds, (const bf16_t*)(ws + WS_ACT), DFF, (const bf16_t*)(ws + WS_WDN), DFF, MTOK, DM, DFF, e);
        } else if constexpr (ph == 10) {
            row_pass((const bf16_t*)(ws + WS_H), p.out, p.in[15], p.out, nullptr, (bf16_t*)(ws + WS_X2B), 2);
        } else if constexpr (ph == 11) {
            Epi<EPI_PLAIN> e{}; e.O = (bf16_t*)(ws + WS_E); e.ldc = DM; e.cs = nullptr;
            run_gemm(lds, (const bf16_t*)(ws + WS_PB), PLE, (const bf16_t*)(ws + WS_WPLE), PLE, MTOK, DM, PLE, e);
            Epi<EPI_PLE> e2{}; e2.O = (bf16_t*)(ws + WS_Z); e2.ldc = DM; e2.X1 = (const bf16_t*)(ws + WS_E); e2.ldx = DM;
            run_gemm(lds, (const bf16_t*)(ws + WS_X2B), DM, (const bf16_t*)(ws + WS_WPGATE), DM, MTOK, DM, DM, e2);
        } else if constexpr (ph == 12) {
            row_pass((const bf16_t*)(ws + WS_Z), p.out, p.in[18], p.out, nullptr, nullptr, 0);
        }
    }
}


template <int PH> __global__ __launch_bounds__(512, 2) void k_phase(Params p) {
    extern __shared__ __attribute__((aligned(16))) unsigned char shm[];
    run_phase<PH>(p, shm);
}
#if N_LAUNCH_MODE == 1
__global__ __launch_bounds__(512, 2) void mega(Params p) {
    extern __shared__ __attribute__((aligned(16))) unsigned char shm[];
    cg::grid_group grid = cg::this_grid();
    run_phase<0>(p, shm); grid.sync();
    run_phase<1>(p, shm); grid.sync();
    run_phase<2>(p, shm); grid.sync();
    run_phase<3>(p, shm); grid.sync();
    run_phase<4>(p, shm); grid.sync();
    run_phase<5>(p, shm); grid.sync();
    run_phase<6>(p, shm); grid.sync();
    run_phase<7>(p, shm); grid.sync();
    run_phase<8>(p, shm); grid.sync();
    run_phase<9>(p, shm); grid.sync();
    run_phase<10>(p, shm); grid.sync();
    run_phase<11>(p, shm); grid.sync();
    run_phase<12>(p, shm);
}
#endif
template <int PH> static void launch_phase(const Params& p, int grid, hipStream_t stream) {
    (void)hipFuncSetAttribute((const void*)k_phase<PH>, hipFuncAttributeMaxDynamicSharedMemorySize, STAGE_BYTES);
    hipLaunchKernelGGL(k_phase<PH>, dim3(grid), dim3(512), STAGE_BYTES, stream, p);
}
extern "C" void kernel_launch(void* const* d_in, const int* in_sizes, int n_in, void* d_out, int out_size, void* d_ws, size_t ws_size, hipStream_t stream) {
    static int grid = 0;
    if (grid == 0) {
        int dev = 0, cus = 0, per_cu = 0;
        (void)hipGetDevice(&dev);
        (void)hipDeviceGetAttribute(&cus, hipDeviceAttributeMultiprocessorCount, dev);
#if N_LAUNCH_MODE == 1
        (void)hipFuncSetAttribute((const void*)mega, hipFuncAttributeMaxDynamicSharedMemorySize, STAGE_BYTES);
        (void)hipOccupancyMaxActiveBlocksPerMultiprocessor(&per_cu, (const void*)mega, 512, STAGE_BYTES);
#endif
        if (per_cu < 1) per_cu = 1;
        grid = cus * per_cu;
        if (grid > 256) grid = 256;
        if (n_in != 19 || ws_size < 484 * MiB) { fprintf(stderr, "kernel_launch: unexpected n_in %d / ws_size %zu\n", n_in, ws_size); }
    }
    Params p{};
    for (int i = 0; i < 19; ++i) p.in[i] = (const float*)d_in[i];
    p.out = (float*)d_out; p.ws = (unsigned char*)d_ws;
    p.ph_lo = 0; p.ph_hi = NPHASE;
#if N_LAUNCH_MODE == 1
    void* args[] = {&p};
    hipError_t e = hipLaunchCooperativeKernel((const void*)mega, dim3(grid), dim3(512), args, STAGE_BYTES, stream);
    if (e != hipSuccess) fprintf(stderr, "cooperative launch failed: %s (grid %d)\n", hipGetErrorString(e), grid);
#else
    launch_phase<0>(p, grid, stream); launch_phase<1>(p, grid, stream); launch_phase<2>(p, grid, stream); launch_phase<3>(p, grid, stream);
    launch_phase<4>(p, grid, stream); launch_phase<5>(p, grid, stream); launch_phase<6>(p, grid, stream); launch_phase<7>(p, grid, stream);
    launch_phase<8>(p, grid, stream); launch_phase<9>(p, grid, stream); launch_phase<10>(p, grid, stream); launch_phase<11>(p, grid, stream);
    launch_phase<12>(p, grid, stream);
#endif
}
```

```cpp
#include <hip/hip_runtime.h>
#include <hip/hip_cooperative_groups.h>
#include <cstdio>
namespace cg = cooperative_groups;

#define LAS __attribute__((address_space(3)))
typedef unsigned short bf16_t;
typedef short bf16x8 __attribute__((ext_vector_type(8)));
typedef float f32x4 __attribute__((ext_vector_type(4)));
typedef float f32x16 __attribute__((ext_vector_type(16)));
typedef unsigned u32x4 __attribute__((ext_vector_type(4)));
typedef unsigned u32x2 __attribute__((ext_vector_type(2)));

constexpr int MTOK = 16384, DM = 2048, SEQ = 4096, AW = 1024, PW = 1024, DFF = 5632, UPW = 11264, PLE = 256;
constexpr float EPS = 1e-6f;
constexpr float LOG2E = 1.4426950408889634f;
constexpr size_t MiB = 1048576;
constexpr size_t WS_WIN = 0, WS_WAB = 32 * MiB, WS_WPG = 36 * MiB, WS_WPB = 37 * MiB, WS_WOUT = 41 * MiB, WS_WUP = 49 * MiB, WS_WDN = 93 * MiB, WS_WPLE = 115 * MiB, WS_WPGATE = 116 * MiB;
constexpr size_t WS_Q = 124 * MiB, WS_K = 156 * MiB, WS_U = 188 * MiB, WS_VT = 220 * MiB, WS_GA = 252 * MiB, WS_GP = 316 * MiB;
constexpr size_t WS_H = 380 * MiB, WS_AO = 380 * MiB, WS_P2 = 412 * MiB, WS_P1 = 444 * MiB, WS_PB = 476 * MiB;
constexpr size_t WS_BAR = 500 * MiB, WS_XCH = 501 * MiB;
constexpr int XCNT_WORD0 = 4096;
constexpr size_t WS_MIXED = 124 * MiB, WS_TMP = 188 * MiB, WS_Y = 188 * MiB, WS_ACT = 124 * MiB, WS_HALO = 300 * MiB, WS_X2B = 124 * MiB, WS_E = 188 * MiB, WS_Z = 252 * MiB;

struct Params { const float* in[19]; float* out; unsigned char* ws; int ph_lo, ph_hi; };

__device__ __forceinline__ int tidx() { int t = (int)__builtin_amdgcn_workitem_id_x(); asm volatile("" : "+v"(t)); return t; }
typedef __bf16 bf16x2_t __attribute__((ext_vector_type(2)));
typedef float f32x2_t __attribute__((ext_vector_type(2)));
__device__ __forceinline__ unsigned cvt_pk_bf16(float lo, float hi) { const f32x2_t v = {lo, hi}; return __builtin_bit_cast(unsigned, __builtin_convertvector(v, bf16x2_t)); }
__device__ __forceinline__ float bf_lo(unsigned w) { return __uint_as_float(w << 16); }
__device__ __forceinline__ float bf_hi(unsigned w) { return __uint_as_float(w & 0xffff0000u); }
__device__ __forceinline__ float sigmoidf_(float x) { return __builtin_amdgcn_rcpf(1.0f + __builtin_amdgcn_exp2f(-LOG2E * x)); }
__device__ __forceinline__ float wave_sum(float v) {
#pragma unroll
    for (int o = 32; o; o >>= 1) v += __shfl_xor(v, o);
    return v;
}
__device__ __forceinline__ float dpp_ror1(float x) { return __int_as_float(__builtin_amdgcn_mov_dpp(__float_as_int(x), 0x121, 0xF, 0xF, false)); }
__device__ __forceinline__ float dpp_ror2(float x) { return __int_as_float(__builtin_amdgcn_mov_dpp(__float_as_int(x), 0x122, 0xF, 0xF, false)); }
__device__ __forceinline__ float dpp_shr1(float x) { return __int_as_float(__builtin_amdgcn_update_dpp(0, __float_as_int(x), 0x111, 0xF, 0xF, true)); }
__device__ __forceinline__ f32x4 shr1v(f32x4 x) { return (f32x4){dpp_shr1(x[0]), dpp_shr1(x[1]), dpp_shr1(x[2]), dpp_shr1(x[3])}; }
__device__ __forceinline__ f32x4 ror1v(f32x4 x) { return (f32x4){dpp_ror1(x[0]), dpp_ror1(x[1]), dpp_ror1(x[2]), dpp_ror1(x[3])}; }
__device__ __forceinline__ f32x4 ror2v(f32x4 x) { return (f32x4){dpp_ror2(x[0]), dpp_ror2(x[1]), dpp_ror2(x[2]), dpp_ror2(x[3])}; }
__device__ __forceinline__ float gelu_mul(float g, float v) {
    const float u = g * (0.7978845608f + 0.0356774081f * g * g);
    return g * v * __builtin_amdgcn_rcpf(1.0f + __builtin_amdgcn_exp2f(-2.0f * LOG2E * u));
}

constexpr int BM = 256, BK = 64, HALF = 128, HTB = HALF * BK * 2, STAGE_BYTES = 8 * HTB, CW_OFF = STAGE_BYTES + 1024  , LDS_BYTES = CW_OFF + 8192, NXCD = 8, WGM = 8;
__host__ __device__ __forceinline__ int lds_byte(int r, int c) { const int st = (r >> 4) * 2 + (c >> 5), rr = r & 15, cc = c & 31, ob = rr * 64 + cc * 2; return st * 1024 + (ob ^ (((ob >> 9) & 1) << 5)); }
__host__ __device__ __forceinline__ void stage_rc(int b, int& R, int& C) { const int st = b / 1024, sb = b % 1024, swz = sb ^ (((sb >> 9) & 1) << 5); R = (st >> 1) * 16 + swz / 64; C = (st & 1) * 32 + (swz % 64) / 2; }
__host__ __device__ __forceinline__ int perm32(int rho) { const int n = rho >> 4, i = rho & 15; return 8 * (i >> 2) + 4 * n + (i & 3); }

struct Unit { int pm, pn; };
struct Gemm { const bf16_t* A; const bf16_t* Bt; int M, N, K, lda, ldb; };
struct StaticOrder {
    int nM, nN, nwg, G, c;
    __device__ void init(int M, int N, int G_, int c_) { nM = M / BM; nN = N / BM; nwg = nM * nN; G = G_; c = c_; }
    __device__ bool next(int i, Unit& u) const {
        const long L = (long)i * G + c; if (L >= nwg) return false;
        int wgid = (int)L; { const int q = nwg / NXCD, r = nwg % NXCD, xcd = wgid % NXCD, off = wgid / NXCD; wgid = (xcd < r ? xcd * (q + 1) : r * (q + 1) + (xcd - r) * q) + off; }
        const int nig = WGM * nN, gid = wgid / nig, fm = gid * WGM, gsz = (nM - fm) < WGM ? (nM - fm) : WGM;
        u.pm = fm + ((wgid % nig) % gsz); u.pn = (wgid % nig) / gsz; return true;
    }
};

struct PanelOrder {
    int nwg, G, c;
    __device__ void init(int M, int N, int G_, int c_) { nwg = (M / BM) * (N / BM); G = G_; c = c_; }
    __device__ bool next(int i, Unit& u) const {
        if (i * G + c >= nwg) return false;
        const int x = c & 7, rank = c >> 3;
        u.pm = i * 32 + 4 * x + (rank & 3); u.pn = rank >> 2; return true;
    }
};
enum { EPI_PROJ = 0, EPI_PLAIN = 1, EPI_GATE1 = 2, EPI_GATE2 = 3, EPI_UP = 4, EPI_PLE = 5, EPI_PLEF = 6, EPI_DOWNF = 7, EPI_OUTF = 8 };
__device__ __forceinline__ void row_rs_exchange(const f32x4 (&acc)[2][2][4][2], const Unit& u, int wr, int wc, int fr, int fq, LAS unsigned char* ldsp, float* xch, unsigned* cnt) {
    const int tid = tidx();
    LAS float* part = (LAS float*)(ldsp + CW_OFF);
    LAS float* rsv = (LAS float*)(ldsp + CW_OFF + 4096);
#pragma unroll
    for (int ai = 0; ai < 2; ++ai)
#pragma unroll
        for (int m = 0; m < 4; ++m) {
            float ps = 0.f;
#pragma unroll
            for (int bj = 0; bj < 2; ++bj)
#pragma unroll
                for (int n = 0; n < 2; ++n)
#pragma unroll
                    for (int k = 0; k < 4; ++k) ps += acc[ai][bj][m][n][k] * acc[ai][bj][m][n][k];
            ps += __shfl_xor(ps, 16); ps += __shfl_xor(ps, 32);
            if (fq == 0) part[(ai * HALF + wr * 64 + m * 16 + fr) * 4 + wc] = ps;
        }
    __syncthreads();
    if (tid < 256) {
        const float sp = (part[tid * 4 + 0] + part[tid * 4 + 1]) + (part[tid * 4 + 2] + part[tid * 4 + 3]);
        __hip_atomic_store(xch + ((size_t)(u.pm * 8 + u.pn) * 256 + tid), sp, __ATOMIC_RELAXED, __HIP_MEMORY_SCOPE_AGENT);
    }
    asm volatile("s_waitcnt vmcnt(0)" ::: "memory");
    __syncthreads();
    if (tid == 0) {
        unsigned* cp = cnt + u.pm * 64;
        __hip_atomic_fetch_add(cp, 1u, __ATOMIC_RELAXED, __HIP_MEMORY_SCOPE_AGENT);
        unsigned sp = 0;
        while (__hip_atomic_load(cp, __ATOMIC_RELAXED, __HIP_MEMORY_SCOPE_AGENT) < 8u) { __builtin_amdgcn_s_sleep(1); if (++sp > (1u << 20)) break; }
    }
    __syncthreads();
    if (tid < 256) {
        float tot = 0.f;
#pragma unroll
        for (int j = 0; j < 8; ++j) tot += __hip_atomic_load(xch + ((size_t)(u.pm * 8 + j) * 256 + tid), __ATOMIC_RELAXED, __HIP_MEMORY_SCOPE_AGENT);
        rsv[tid] = rsqrtf(tot * (1.0f / DM) + EPS);
    }
    __syncthreads();
}
template <int MODE> struct Epi {
    static constexpr bool PERMA = (MODE == EPI_UP);
    static constexpr bool PREFETCH = (MODE == EPI_UP);
    LAS unsigned char* ldsp;
    __device__ __forceinline__ void prefetch(const Unit& u, int wid, int lane) const {
        if constexpr (MODE == EPI_UP) {
            const int seg = lane >> 3, tab = seg >> 1, bj = seg & 1;
            const float* src = (tab < 3 ? cs + tab * UPW : cb) + bj * DFF + u.pn * 128 + (wid & 3) * 32 + (lane & 7) * 4;
            __builtin_amdgcn_global_load_lds((const unsigned*)src, (LAS unsigned*)(ldsp + CW_OFF + wid * 1024), 16, 0, 0);
        }
    }
    bf16_t* O; int ldc;
    const bf16_t* X1; const bf16_t* X2; int ldx;
    const float* cs; const float* cb; float* halo; unsigned char* ws; float qscale;
    float* xch; unsigned* cnt; float* Of; const float* Xf; bf16_t* Ob;
    __device__ __forceinline__ void operator()(f32x4 (&acc)[2][2][4][2], const Unit& u, int wr, int wc, int fr, int fq) const {
        int row0 = u.pm * BM + wr * 64 + fr;
        int colb = u.pn * BM + wc * 32 + 8 * fq;
        asm volatile("" : "+v"(row0), "+v"(colb));
        if constexpr (MODE == EPI_PLEF) {
            if (wr == 0) __builtin_amdgcn_s_barrier();
#pragma unroll
            for (int bj = 0; bj < 2; ++bj) {
                const int c = colb + bj * HALF;
#pragma unroll
                for (int ai = 0; ai < 2; ++ai)
#pragma unroll
                    for (int m = 0; m < 4; ++m) {
                        const int r = row0 + ai * HALF + m * 16;
                        const u32x4 e = *(const u32x4*)(X1 + (size_t)r * ldx + c);
                        f32x4& v0 = acc[ai][bj][m][0]; f32x4& v1 = acc[ai][bj][m][1];
                        v0[0] = sigmoidf_(v0[0]) * bf_lo(e[0]); v0[1] = sigmoidf_(v0[1]) * bf_hi(e[0]); v0[2] = sigmoidf_(v0[2]) * bf_lo(e[1]); v0[3] = sigmoidf_(v0[3]) * bf_hi(e[1]);
                        v1[0] = sigmoidf_(v1[0]) * bf_lo(e[2]); v1[1] = sigmoidf_(v1[1]) * bf_hi(e[2]); v1[2] = sigmoidf_(v1[2]) * bf_lo(e[3]); v1[3] = sigmoidf_(v1[3]) * bf_hi(e[3]);
                    }
            }
            row_rs_exchange(acc, u, wr, wc, fr, fq, ldsp, xch, cnt);
            LAS float* rsv = (LAS float*)(ldsp + CW_OFF + 4096);
#pragma unroll
            for (int bj = 0; bj < 2; ++bj) {
                const int c = colb + bj * HALF;
                const f32x4 g0 = *(const f32x4*)(cs + c), g1 = *(const f32x4*)(cs + c + 4);
#pragma unroll
                for (int ai = 0; ai < 2; ++ai)
#pragma unroll
                    for (int m = 0; m < 4; ++m) {
                        const int r = row0 + ai * HALF + m * 16, rl = r & (BM - 1);
                        const float rs = rsv[rl];
                        const u32x4 xb = *(const u32x4*)(X2 + (size_t)r * ldx + c);
                        const f32x4 v0 = acc[ai][bj][m][0], v1 = acc[ai][bj][m][1];
                        f32x4 o0, o1;
                        o0[0] = bf_lo(xb[0]) + v0[0] * rs * g0[0]; o0[1] = bf_hi(xb[0]) + v0[1] * rs * g0[1]; o0[2] = bf_lo(xb[1]) + v0[2] * rs * g0[2]; o0[3] = bf_hi(xb[1]) + v0[3] * rs * g0[3];
                        o1[0] = bf_lo(xb[2]) + v1[0] * rs * g1[0]; o1[1] = bf_hi(xb[2]) + v1[1] * rs * g1[1]; o1[2] = bf_lo(xb[3]) + v1[2] * rs * g1[2]; o1[3] = bf_hi(xb[3]) + v1[3] * rs * g1[3];
                        float* op = Of + (size_t)r * DM + c;
                        *(f32x4*)op = o0; *(f32x4*)(op + 4) = o1;
                    }
            }
            if (wr == 1) __builtin_amdgcn_s_barrier();
        } else
        if constexpr (MODE == EPI_DOWNF) {
            if (wr == 0) __builtin_amdgcn_s_barrier();
            row_rs_exchange(acc, u, wr, wc, fr, fq, ldsp, xch, cnt);
            LAS float* rsv = (LAS float*)(ldsp + CW_OFF + 4096);
#pragma unroll
            for (int bj = 0; bj < 2; ++bj) {
                const int c = colb + bj * HALF;
                const f32x4 g0 = *(const f32x4*)(cs + c), g1 = *(const f32x4*)(cs + c + 4);
#pragma unroll
                for (int ai = 0; ai < 2; ++ai)
#pragma unroll
                    for (int m = 0; m < 4; ++m) {
                        const int r = row0 + ai * HALF + m * 16, rl = r & (BM - 1);
                        const float rs = rsv[rl];
                        const u32x4 xb = *(const u32x4*)(X2 + (size_t)r * ldx + c);
                        const f32x4 v0 = acc[ai][bj][m][0], v1 = acc[ai][bj][m][1];
                        u32x4 o;
                        o[0] = cvt_pk_bf16(bf_lo(xb[0]) + v0[0] * rs * g0[0], bf_hi(xb[0]) + v0[1] * rs * g0[1]); o[1] = cvt_pk_bf16(bf_lo(xb[1]) + v0[2] * rs * g0[2], bf_hi(xb[1]) + v0[3] * rs * g0[3]);
                        o[2] = cvt_pk_bf16(bf_lo(xb[2]) + v1[0] * rs * g1[0], bf_hi(xb[2]) + v1[1] * rs * g1[1]); o[3] = cvt_pk_bf16(bf_lo(xb[3]) + v1[2] * rs * g1[2], bf_hi(xb[3]) + v1[3] * rs * g1[3]);
                        *(u32x4*)(O + (size_t)r * ldc + c) = o;
                    }
            }
            if (wr == 1) __builtin_amdgcn_s_barrier();
        } else if constexpr (MODE == EPI_OUTF) {
            if (wr == 0) __builtin_amdgcn_s_barrier();
            const __attribute__((address_space(4))) Params* kq = (const __attribute__((address_space(4))) Params*)__builtin_amdgcn_kernarg_segment_ptr();
            asm volatile("" : "+s"(kq));
            bf16_t* const O = (bf16_t*)kq->out; unsigned char* const wsp = kq->ws; const float* const cs = kq->in[9]; const float* const cb = kq->in[10];
            bf16_t* const Ob = (bf16_t*)(wsp + WS_H);
            float* const xch = (float*)(wsp + WS_XCH) + 1 * 64 * 8 * 256; unsigned* const cnt = (unsigned*)(wsp + WS_BAR) + XCNT_WORD0 + 1 * 64 * 64;
            row_rs_exchange(acc, u, wr, wc, fr, fq, ldsp, xch, cnt);
            LAS float* rsv = (LAS float*)(ldsp + CW_OFF + 4096);
#pragma unroll
            for (int bj = 0; bj < 2; ++bj) {
                __builtin_amdgcn_sched_barrier(0);
                const int c = colb + bj * HALF;
                const f32x4 g0 = *(const f32x4*)(cs + c), g1 = *(const f32x4*)(cs + c + 4);
#pragma unroll
                for (int ai = 0; ai < 2; ++ai)
#pragma unroll
                    for (int m = 0; m < 4; ++m) {
                        const int r = row0 + ai * HALF + m * 16, rl = r & (BM - 1);
                        const float rs = rsv[rl];
                        const unsigned off = (unsigned)(r * DM + c) * 2u;
                        const u32x4 xb = *(const u32x4*)((const char*)O + (size_t)MTOK * DM * 2 + off);
                        f32x4& v0 = acc[ai][bj][m][0]; f32x4& v1 = acc[ai][bj][m][1];
                        v0[0] = bf_lo(xb[0]) + v0[0] * rs * g0[0]; v0[1] = bf_hi(xb[0]) + v0[1] * rs * g0[1]; v0[2] = bf_lo(xb[1]) + v0[2] * rs * g0[2]; v0[3] = bf_hi(xb[1]) + v0[3] * rs * g0[3];
                        v1[0] = bf_lo(xb[2]) + v1[0] * rs * g1[0]; v1[1] = bf_hi(xb[2]) + v1[1] * rs * g1[1]; v1[2] = bf_lo(xb[3]) + v1[2] * rs * g1[2]; v1[3] = bf_hi(xb[3]) + v1[3] * rs * g1[3];
                    }
                asm volatile("" ::: "memory");
            }
#pragma unroll
            for (int bj = 0; bj < 2; ++bj)
#pragma unroll
                for (int ai = 0; ai < 2; ++ai)
#pragma unroll
                    for (int m = 0; m < 4; ++m) {
                        const int r = row0 + ai * HALF + m * 16;
                        const unsigned off = (unsigned)(r * DM + colb + bj * HALF) * 2u;
                        const f32x4 v0 = acc[ai][bj][m][0], v1 = acc[ai][bj][m][1];
                        u32x4 o; o[0] = cvt_pk_bf16(v0[0], v0[1]); o[1] = cvt_pk_bf16(v0[2], v0[3]); o[2] = cvt_pk_bf16(v1[0], v1[1]); o[3] = cvt_pk_bf16(v1[2], v1[3]);
                        *(u32x4*)((char*)O + off) = o;
                    }
            row_rs_exchange(acc, u, wr, wc, fr, fq, ldsp, xch + 64 * 8 * 256, cnt + 64 * 64);
#pragma unroll
            for (int bj = 0; bj < 2; ++bj) {
                const int c = colb + bj * HALF;
                const f32x4 g0 = *(const f32x4*)(cb + c), g1 = *(const f32x4*)(cb + c + 4);
#pragma unroll
                for (int ai = 0; ai < 2; ++ai)
#pragma unroll
                    for (int m = 0; m < 4; ++m) {
                        const int r = row0 + ai * HALF + m * 16, rl = r & (BM - 1);
                        const float rs = rsv[rl];
                        const unsigned off = (unsigned)(r * DM + c) * 2u;
                        const f32x4 h0 = acc[ai][bj][m][0] * g0 * rs, h1 = acc[ai][bj][m][1] * g1 * rs;
                        u32x4 oh; oh[0] = cvt_pk_bf16(h0[0], h0[1]); oh[1] = cvt_pk_bf16(h0[2], h0[3]); oh[2] = cvt_pk_bf16(h1[0], h1[1]); oh[3] = cvt_pk_bf16(h1[2], h1[3]);
                        *(u32x4*)((char*)Ob + off) = oh;
                    }
            }
            if (wr == 1) __builtin_amdgcn_s_barrier();
        } else
        if constexpr (MODE == EPI_UP) {
            const int ch0 = u.pn * 128 + wc * 32 + 8 * fq;
            const int blk0 = u.pm * 4 + wr;
            const int rowp = u.pm * BM + wr * 64 + 4 * fr;
            const LAS unsigned char* wp = ldsp + CW_OFF + (wr * 4 + wc) * 1024 + fq * 32;
            if (fr == 0 || fr == 15) {
                const bool lo = fr == 0;
                float* hp0 = halo + (size_t)(blk0 * 4 + (lo ? 0 : 2)) * UPW + ch0;
#pragma unroll
                for (int ai = 0; ai < 2; ++ai)
#pragma unroll
                    for (int bj = 0; bj < 2; ++bj)
#pragma unroll
                        for (int n = 0; n < 2; ++n) {
                            const f32x4 a0 = acc[ai][bj][0][n], a1 = acc[ai][bj][1][n], a2 = acc[ai][bj][2][n], a3 = acc[ai][bj][3][n];
                            f32x4 va, vb;
#pragma unroll
                            for (int e = 0; e < 4; ++e) { va[e] = lo ? a0[e] : a2[e]; vb[e] = lo ? a1[e] : a3[e]; }
                            float* hp = hp0 + (size_t)(ai * 8) * UPW + bj * DFF + 4 * n;
                            *(f32x4*)hp = va; *(f32x4*)(hp + UPW) = vb;
                        }
            }
#pragma unroll
            for (int n = 0; n < 2; ++n) {
                const int ch = ch0 + 4 * n;
#pragma unroll
                for (int ai = 0; ai < 2; ++ai) {
                    f32x4 Gc[4];
#pragma unroll
                    for (int bj = 0; bj < 2; ++bj) {
                        const int cc = bj * DFF + ch;
                        const LAS unsigned char* wq = wp + bj * 128 + n * 16;
                        const f32x4 w0 = *(const LAS f32x4*)(wq), w1 = *(const LAS f32x4*)(wq + 256), w2 = *(const LAS f32x4*)(wq + 512), bb = *(const LAS f32x4*)(wq + 768);
                        const f32x4 X0 = acc[ai][bj][0][n], X1v = acc[ai][bj][1][n], X2v = acc[ai][bj][2][n], X3 = acc[ai][bj][3][n];
                        const f32x4 S3 = shr1v(X3), S2 = shr1v(X2v);
                        f32x4 cv[4];
                        cv[0] = bb + w2 * X0 + w1 * S3 + w0 * S2;
                        cv[1] = bb + w2 * X1v + w1 * X0 + w0 * S3;
                        cv[2] = bb + w2 * X2v + w1 * X1v + w0 * X0;
                        cv[3] = bb + w2 * X3 + w1 * X2v + w0 * X1v;
#pragma unroll
                        for (int m = 0; m < 4; ++m) {
                            if (bj == 0) Gc[m] = cv[m];
                            else {
                                const f32x4 g = Gc[m];
                                u32x2 o; o[0] = cvt_pk_bf16(gelu_mul(g[0], cv[m][0]), gelu_mul(g[1], cv[m][1])); o[1] = cvt_pk_bf16(gelu_mul(g[2], cv[m][2]), gelu_mul(g[3], cv[m][3]));
                                *(u32x2*)(O + (size_t)(rowp + ai * HALF + m) * DFF + ch) = o;
                            }
                        }
                    }
                }
            }
        } else {
            bf16_t* base = O; int ld = ldc, coff = 0; float sc = 1.0f;
            if constexpr (MODE == EPI_PROJ) {
                const int pn = u.pn;
                if (pn < 4) { base = (bf16_t*)(ws + WS_Q); ld = 1024; coff = 0; sc = qscale; }
                else if (pn < 8) { base = (bf16_t*)(ws + WS_K); ld = 1024; coff = 1024; }
                else if (pn < 12) { base = (bf16_t*)(ws + WS_U); ld = 1024; coff = 2048; }
                else if (pn < 20) { base = (bf16_t*)(ws + WS_GA); ld = 2048; coff = 3072; }
                else { base = (bf16_t*)(ws + WS_GP); ld = 2048; coff = 5120; }
            }
#pragma unroll
            for (int bj = 0; bj < 2; ++bj) {
                const int c = colb + bj * HALF;
                f32x4 cs0 = (f32x4){sc, sc, sc, sc}, cs1 = cs0;
                if constexpr (MODE == EPI_PLAIN) { if (cs) { cs0 = *(const f32x4*)(cs + c); cs1 = *(const f32x4*)(cs + c + 4); } }
#pragma unroll
                for (int ai = 0; ai < 2; ++ai)
#pragma unroll
                    for (int m = 0; m < 4; ++m) {
                        const int r = row0 + ai * HALF + m * 16;
                        f32x4 v0 = acc[ai][bj][m][0] * cs0, v1 = acc[ai][bj][m][1] * cs1;
                        if constexpr (MODE == EPI_GATE1 || MODE == EPI_GATE2) {
                            const u32x4 g = *(const u32x4*)(X1 + (size_t)r * ldx + c);
                            v0[0] *= sigmoidf_(bf_lo(g[0])); v0[1] *= sigmoidf_(bf_hi(g[0])); v0[2] *= sigmoidf_(bf_lo(g[1])); v0[3] *= sigmoidf_(bf_hi(g[1]));
                            v1[0] *= sigmoidf_(bf_lo(g[2])); v1[1] *= sigmoidf_(bf_hi(g[2])); v1[2] *= sigmoidf_(bf_lo(g[3])); v1[3] *= sigmoidf_(bf_hi(g[3]));
                            if constexpr (MODE == EPI_GATE2) {
                                const u32x4 t = *(const u32x4*)(X2 + (size_t)r * ldx + c);
                                v0[0] += bf_lo(t[0]); v0[1] += bf_hi(t[0]); v0[2] += bf_lo(t[1]); v0[3] += bf_hi(t[1]);
                                v1[0] += bf_lo(t[2]); v1[1] += bf_hi(t[2]); v1[2] += bf_lo(t[3]); v1[3] += bf_hi(t[3]);
                            }
                        }
                        if constexpr (MODE == EPI_PLE) {
                            const u32x4 e = *(const u32x4*)(X1 + (size_t)r * ldx + c);
                            v0[0] = sigmoidf_(v0[0]) * bf_lo(e[0]); v0[1] = sigmoidf_(v0[1]) * bf_hi(e[0]); v0[2] = sigmoidf_(v0[2]) * bf_lo(e[1]); v0[3] = sigmoidf_(v0[3]) * bf_hi(e[1]);
                            v1[0] = sigmoidf_(v1[0]) * bf_lo(e[2]); v1[1] = sigmoidf_(v1[1]) * bf_hi(e[2]); v1[2] = sigmoidf_(v1[2]) * bf_lo(e[3]); v1[3] = sigmoidf_(v1[3]) * bf_hi(e[3]);
                        }
                        u32x4 o; o[0] = cvt_pk_bf16(v0[0], v0[1]); o[1] = cvt_pk_bf16(v0[2], v0[3]); o[2] = cvt_pk_bf16(v1[0], v1[1]); o[3] = cvt_pk_bf16(v1[2], v1[3]);
                        *(u32x4*)(base + (size_t)r * ld + (c - coff)) = o;
                    }
            }
        }
    }
};

template <class EpiT, class Sched>
__device__ __forceinline__ void gemm_phase(LAS unsigned char* lds, const Gemm g, const Sched& S, const EpiT& E) {
    const int tid = tidx(), wid = __builtin_amdgcn_readfirstlane(tid >> 6), lane = tid & 63, wr = wid >> 2, wc = wid & 3, fr = lane & 15, fq = lane >> 4;
    const int K = g.K, nt = K / BK;
    unsigned voffA[2], voffB[2];
#pragma unroll
    for (int i = 0; i < 2; ++i) { int R, C; stage_rc(tid * 16 + i * 8192, R, C); const int Rb = (R & ~31) + perm32(R & 31);
        const int Ra = EpiT::PERMA ? ((R & ~63) + 4 * (R & 15) + ((R >> 4) & 3)) : R;
        voffA[i] = (unsigned)(Ra * g.lda + C) * 2u; voffB[i] = (unsigned)(Rb * g.ldb + C) * 2u; }
    const size_t kstep = (size_t)(BK * 2);
    const size_t hstepA = (size_t)HALF * g.lda * 2, hstepB = (size_t)HALF * g.ldb * 2;
    const size_t tstepA = 2 * hstepA, tstepB = 2 * hstepB;
    const unsigned ldsw = (unsigned)wid * 1024u;
    const int aoff = lds_byte(wr * 64 + fr, fq * 8), boff = lds_byte(wc * 32 + fr, fq * 8);
#define PG8_SA(b, h) (((b) * 2 + (h)) * HTB)
#define PG8_SB(b, h) ((4 + (b) * 2 + (h)) * HTB)
#define PG8_STAGE(bufoff, gbase, voff) do { _Pragma("unroll") for (int _i = 0; _i < 2; ++_i) \
        __builtin_amdgcn_global_load_lds((const unsigned*)((const char*)(gbase) + (voff)[_i]), (LAS unsigned*)(lds + (bufoff) + ldsw + _i * 8192), 16, 0, 0); } while (0)
#define PG8_LDA(dst, b, h) do { _Pragma("unroll") for (int m = 0; m < 4; ++m) _Pragma("unroll") for (int k = 0; k < 2; ++k) dst[m][k] = *(const LAS bf16x8*)(lds + PG8_SA(b, h) + aoff + m * 2048 + k * 1024); } while (0)
#define PG8_LDB(dst, b, h) do { _Pragma("unroll") for (int n = 0; n < 2; ++n) _Pragma("unroll") for (int k = 0; k < 2; ++k) dst[n][k] = *(const LAS bf16x8*)(lds + PG8_SB(b, h) + boff + n * 2048 + k * 1024); } while (0)
#define PG8_MMA(ai, bj, At, Bt) do { __builtin_amdgcn_s_setprio(1); _Pragma("unroll") for (int m = 0; m < 4; ++m) _Pragma("unroll") for (int n = 0; n < 2; ++n) _Pragma("unroll") for (int k = 0; k < 2; ++k) \
        acc[ai][bj][m][n] = __builtin_amdgcn_mfma_f32_16x16x32_bf16(Bt[n][k], At[m][k], acc[ai][bj][m][n], 0, 0, 0); __builtin_amdgcn_s_setprio(0); } while (0)
#define PG8_WAIT_V(n) asm volatile("s_waitcnt vmcnt(" #n ")" ::: "memory")
#define PG8_WAIT_L(n) asm volatile("s_waitcnt lgkmcnt(" #n ")" ::: "memory")
#define PG8_BAR __builtin_amdgcn_s_barrier()
#define PG8_SCHED __builtin_amdgcn_sched_barrier(0)
    Unit cur, nxt; int ui = 0;
    if (!S.next(0, cur)) return;
    f32x4 acc[2][2][4][2];
#pragma unroll
    for (int a = 0; a < 2; ++a)
#pragma unroll
        for (int b = 0; b < 2; ++b)
#pragma unroll
            for (int m = 0; m < 4; ++m)
#pragma unroll
                for (int n = 0; n < 2; ++n) acc[a][b][m][n] = (f32x4){0.f, 0.f, 0.f, 0.f};
    bf16x8 At[4][2], B0[2][2], B1[2][2];
    const char* cA = (const char*)g.A + (size_t)cur.pm * tstepA; const char* cB = (const char*)g.Bt + (size_t)cur.pn * tstepB;
    PG8_STAGE(PG8_SB(0, 0), cB, voffB); PG8_STAGE(PG8_SA(0, 0), cA, voffA); PG8_STAGE(PG8_SB(0, 1), cB + hstepB, voffB); PG8_STAGE(PG8_SA(0, 1), cA + hstepA, voffA);
    if (wr == 1) PG8_BAR;
    PG8_WAIT_V(4); PG8_BAR;
    PG8_STAGE(PG8_SB(1, 0), cB + kstep, voffB); PG8_STAGE(PG8_SA(1, 0), cA + kstep, voffA); PG8_STAGE(PG8_SB(1, 1), cB + hstepB + kstep, voffB);
    PG8_WAIT_V(6); PG8_BAR;
    for (;;) {
        const bool has_next = S.next(ui + 1, nxt);
        const char* nA = has_next ? (const char*)g.A + (size_t)nxt.pm * tstepA : cA; const char* nB = has_next ? (const char*)g.Bt + (size_t)nxt.pn * tstepB : cB;
        for (int t = 0; t < nt; t += 2) {
            const bool last = (t == nt - 2);
            if constexpr (EpiT::PREFETCH) { if (last) E.prefetch(cur, wid, lane); }
            const char* a1 = cA + (size_t)(t + 1) * kstep;
            const char* a2 = last ? nA : cA + (size_t)(t + 2) * kstep; const char* b2 = last ? nB : cB + (size_t)(t + 2) * kstep;
            const char* a3 = a2 + kstep; const char* b3 = b2 + kstep;
            PG8_LDB(B0, 0, 0); PG8_SCHED; PG8_LDA(At, 0, 0); PG8_STAGE(PG8_SA(1, 1), a1 + hstepA, voffA);
            PG8_WAIT_L(8); PG8_BAR; PG8_WAIT_L(0); PG8_MMA(0, 0, At, B0); PG8_BAR; PG8_SCHED;
            PG8_LDB(B1, 0, 1); PG8_STAGE(PG8_SB(0, 0), b2, voffB);
            PG8_BAR; PG8_WAIT_L(0); PG8_MMA(0, 1, At, B1); PG8_BAR;
            PG8_LDA(At, 0, 1); PG8_STAGE(PG8_SA(0, 0), a2, voffA);
            PG8_BAR; PG8_WAIT_L(0); PG8_MMA(1, 0, At, B0); PG8_BAR; PG8_SCHED;
            PG8_STAGE(PG8_SB(0, 1), b2 + hstepB, voffB);
            PG8_WAIT_V(6); PG8_BAR; PG8_MMA(1, 1, At, B1); PG8_BAR;
            PG8_LDB(B0, 1, 0); PG8_SCHED; PG8_LDA(At, 1, 0); PG8_STAGE(PG8_SA(0, 1), a2 + hstepA, voffA);
            PG8_WAIT_L(8); PG8_BAR; PG8_WAIT_L(0); PG8_MMA(0, 0, At, B0); PG8_BAR; PG8_SCHED;
            PG8_LDB(B1, 1, 1); PG8_STAGE(PG8_SB(1, 0), b3, voffB);
            PG8_BAR; PG8_WAIT_L(0); PG8_MMA(0, 1, At, B1); PG8_BAR;
            PG8_LDA(At, 1, 1); PG8_STAGE(PG8_SA(1, 0), a3, voffA);
            PG8_BAR; PG8_WAIT_L(0); PG8_MMA(1, 0, At, B0); PG8_BAR; PG8_SCHED;
            PG8_STAGE(PG8_SB(1, 1), b3 + hstepB, voffB);
            PG8_WAIT_V(6); PG8_BAR; PG8_MMA(1, 1, At, B1); PG8_BAR;
        }
        E(acc, cur, wr, wc, fr, fq);
        if (!has_next) break;
#pragma unroll
        for (int a = 0; a < 2; ++a)
#pragma unroll
            for (int b = 0; b < 2; ++b)
#pragma unroll
                for (int m = 0; m < 4; ++m)
#pragma unroll
                    for (int n = 0; n < 2; ++n) acc[a][b][m][n] = (f32x4){0.f, 0.f, 0.f, 0.f};
        cur = nxt; cA = nA; cB = nB; ++ui;
    }
    PG8_WAIT_V(0);
    if (wr == 0) PG8_BAR;
    PG8_BAR;
#undef PG8_SA
#undef PG8_SB
#undef PG8_STAGE
#undef PG8_LDA
#undef PG8_LDB
#undef PG8_MMA
#undef PG8_WAIT_V
#undef PG8_WAIT_L
#undef PG8_BAR
#undef PG8_SCHED
}

template <int MODE>
__device__ __forceinline__ void run_gemm_panel(LAS unsigned char* lds, const bf16_t* A, int lda, const bf16_t* Bt, int ldb, int M, int N, int K, const Epi<MODE>& E) {
    Gemm g; g.A = A; g.Bt = Bt; g.M = M; g.N = N; g.K = K; g.lda = lda; g.ldb = ldb;
    PanelOrder S; S.init(M, N, (int)gridDim.x, (int)blockIdx.x);
    gemm_phase(lds, g, S, E);
}
template <int MODE>
__device__ __forceinline__ void run_gemm(LAS unsigned char* lds, const bf16_t* A, int lda, const bf16_t* Bt, int ldb, int M, int N, int K, const Epi<MODE>& E, int crot = 0) {
    Gemm g; g.A = A; g.Bt = Bt; g.M = M; g.N = N; g.K = K; g.lda = lda; g.ldb = ldb;
    int cc = (int)blockIdx.x - crot; if (cc < 0) cc += (int)gridDim.x;
    StaticOrder S; S.init(M, N, (int)gridDim.x, cc);
    gemm_phase(lds, g, S, E);
}

__device__ __forceinline__ void cvt_transpose(const float* __restrict__ W, bf16_t* __restrict__ Wt, int K, int N, int ldt, int mode, float* tile) {
    const int tid = tidx(), ntn = N / 64, ntk = K / 64, ntile = ntn * ntk, G = (int)gridDim.x;
    const int kk0 = tid >> 4, n4 = (tid & 15) * 4;
    const float4 z4 = make_float4(0.f, 0.f, 0.f, 0.f);
    float4 a0 = z4, a1 = z4, b0 = z4, b1 = z4;
    int t = (int)blockIdx.x;
#define CVT_LOAD(tt, r0, r1) do { const int _tk = (tt) / ntn, _tn = (tt) % ntn; const float* _p = W + (size_t)(_tk * 64 + kk0) * N + _tn * 64 + n4; r0 = *(const float4*)_p; r1 = *(const float4*)(_p + (size_t)32 * N); } while (0)
    if (t < ntile) CVT_LOAD(t, a0, a1);
    if (t + G < ntile) CVT_LOAD(t + G, b0, b1);
    for (; t < ntile; t += G) {
        const int tk = t / ntn, tn = t % ntn;
        const float4 v0 = a0, v1 = a1;
        a0 = b0; a1 = b1;
        if (t + 2 * G < ntile) CVT_LOAD(t + 2 * G, b0, b1);
        tile[(n4 + 0) * 65 + kk0] = v0.x; tile[(n4 + 1) * 65 + kk0] = v0.y; tile[(n4 + 2) * 65 + kk0] = v0.z; tile[(n4 + 3) * 65 + kk0] = v0.w;
        tile[(n4 + 0) * 65 + kk0 + 32] = v1.x; tile[(n4 + 1) * 65 + kk0 + 32] = v1.y; tile[(n4 + 2) * 65 + kk0 + 32] = v1.z; tile[(n4 + 3) * 65 + kk0 + 32] = v1.w;
        __syncthreads();
        {
            const int n = tid >> 3, k8 = (tid & 7) * 8;
            int n0 = tn * 64;
            if (mode == 1) { n0 = n0 < 2048 ? n0 : (n0 < 3072 ? n0 + 5120 : n0 - 1024); }
            else if (mode == 2) { const int bj = n0 >= DFF ? 1 : 0, ch = n0 - bj * DFF; n0 = 256 * (ch >> 7) + 128 * bj + (ch & 127); }
            const float* tp = tile + n * 65 + k8;
            u32x4 o; o[0] = cvt_pk_bf16(tp[0], tp[1]); o[1] = cvt_pk_bf16(tp[2], tp[3]); o[2] = cvt_pk_bf16(tp[4], tp[5]); o[3] = cvt_pk_bf16(tp[6], tp[7]);
            *(u32x4*)(Wt + (size_t)(n0 + n) * ldt + tk * 64 + k8) = o;
        }
        __syncthreads();
    }
#undef CVT_LOAD
}

template <bool XIN_BF16, int XO, bool HN>
__device__ __forceinline__ void row_pass(const bf16_t* __restrict__ y, const void* __restrict__ xin, const float* __restrict__ g1, void* __restrict__ xo, const float* __restrict__ g2, bf16_t* __restrict__ hb) {
    const int lane = tidx() & 63, gw = blockIdx.x * 8 + (tidx() >> 6), nw = gridDim.x * 8;
    for (int row = gw; row < MTOK; row += nw) {
        float4 v[8];
        if constexpr (XIN_BF16) {
            const u32x2* xr = (const u32x2*)((const bf16_t*)xin + (size_t)row * DM);
#pragma unroll
            for (int i = 0; i < 8; ++i) { const u32x2 w = xr[lane + 64 * i]; v[i] = make_float4(bf_lo(w[0]), bf_hi(w[0]), bf_lo(w[1]), bf_hi(w[1])); }
        } else {
            const float4* xr = (const float4*)((const float*)xin + (size_t)row * DM);
#pragma unroll
            for (int i = 0; i < 8; ++i) v[i] = xr[lane + 64 * i];
        }
        if (y) {
            const u32x2* yr = (const u32x2*)(y + (size_t)row * DM);
            float4 yv[8]; float ss = 0.f;
#pragma unroll
            for (int i = 0; i < 8; ++i) { const u32x2 w = yr[lane + 64 * i]; yv[i] = make_float4(bf_lo(w[0]), bf_hi(w[0]), bf_lo(w[1]), bf_hi(w[1])); ss += yv[i].x * yv[i].x + yv[i].y * yv[i].y + yv[i].z * yv[i].z + yv[i].w * yv[i].w; }
            ss = wave_sum(ss);
            const float rs = rsqrtf(ss * (1.0f / DM) + EPS);
#pragma unroll
            for (int i = 0; i < 8; ++i) { const float4 gg = ((const float4*)g1)[lane + 64 * i];
                v[i].x += yv[i].x * rs * gg.x; v[i].y += yv[i].y * rs * gg.y; v[i].z += yv[i].z * rs * gg.z; v[i].w += yv[i].w * rs * gg.w; }
        }
        if constexpr (XO == 1) {
#pragma unroll
            for (int i = 0; i < 8; ++i) ((float4*)((float*)xo + (size_t)row * DM))[lane + 64 * i] = v[i];
        } else if constexpr (XO == 2) {
#pragma unroll
            for (int i = 0; i < 8; ++i) { u32x2 o; o[0] = cvt_pk_bf16(v[i].x, v[i].y); o[1] = cvt_pk_bf16(v[i].z, v[i].w); ((u32x2*)((bf16_t*)xo + (size_t)row * DM))[lane + 64 * i] = o; }
        }
        if constexpr (HN) {
            float ss = 0.f;
#pragma unroll
            for (int i = 0; i < 8; ++i) ss += v[i].x * v[i].x + v[i].y * v[i].y + v[i].z * v[i].z + v[i].w * v[i].w;
            ss = wave_sum(ss);
            const float rs = rsqrtf(ss * (1.0f / DM) + EPS);
#pragma unroll
            for (int i = 0; i < 8; ++i) { const float4 gg = ((const float4*)g2)[lane + 64 * i];
                u32x2 o; o[0] = cvt_pk_bf16(v[i].x * rs * gg.x, v[i].y * rs * gg.y); o[1] = cvt_pk_bf16(v[i].z * rs * gg.z, v[i].w * rs * gg.w);
                ((u32x2*)(hb + (size_t)row * DM))[lane + 64 * i] = o; }
        }
    }
}

__device__ __forceinline__ void x_pass(const float* __restrict__ x, bf16_t* __restrict__ xb, const float* __restrict__ g, bf16_t* __restrict__ hb) {
    const int lane = tidx() & 63, gw = blockIdx.x * 8 + (tidx() >> 6), nw = gridDim.x * 8;
    float4 nx[8];
    int row = gw;
    if (row < MTOK) {
        const float4* xr = (const float4*)(x + (size_t)row * DM);
#pragma unroll
        for (int i = 0; i < 8; ++i) nx[i] = xr[lane + 64 * i];
    }
    for (; row < MTOK; row += nw) {
        float4 v[8];
#pragma unroll
        for (int i = 0; i < 8; ++i) v[i] = nx[i];
        if (row + nw < MTOK) {
            const float4* xr = (const float4*)(x + (size_t)(row + nw) * DM);
#pragma unroll
            for (int i = 0; i < 8; ++i) nx[i] = xr[lane + 64 * i];
        }
        float ss = 0.f;
#pragma unroll
        for (int i = 0; i < 8; ++i) ss += v[i].x * v[i].x + v[i].y * v[i].y + v[i].z * v[i].z + v[i].w * v[i].w;
        ss = wave_sum(ss);
        const float rs = rsqrtf(ss * (1.0f / DM) + EPS);
#pragma unroll
        for (int i = 0; i < 8; ++i) {
            const float4 gg = ((const float4*)g)[lane + 64 * i];
            u32x2 o; o[0] = cvt_pk_bf16(v[i].x, v[i].y); o[1] = cvt_pk_bf16(v[i].z, v[i].w);
            ((u32x2*)(xb + (size_t)row * DM))[lane + 64 * i] = o;
            u32x2 oh; oh[0] = cvt_pk_bf16(v[i].x * rs * gg.x, v[i].y * rs * gg.y); oh[1] = cvt_pk_bf16(v[i].z * rs * gg.z, v[i].w * rs * gg.w);
            ((u32x2*)(hb + (size_t)row * DM))[lane + 64 * i] = oh;
        }
    }
}

template <int W>
__device__ __forceinline__ void pool_group(const bf16_t* __restrict__ U, bf16_t* __restrict__ P1, int grp) {
    const int nthr = gridDim.x * 512;
    for (int it = blockIdx.x * 512 + tidx(); it < MTOK * 32; it += nthr) {
        const int tok = it >> 5, c8 = grp * 256 + (it & 31) * 8, tl = tok & (SEQ - 1);
        const int cnt = (tl + 1) < W ? (tl + 1) : W;
        float s[8] = {0.f, 0.f, 0.f, 0.f, 0.f, 0.f, 0.f, 0.f}, u0[8];
#pragma unroll
        for (int j = 0; j < W; ++j) {
            const bool in = j < cnt;
            const u32x4 v = *(const u32x4*)(U + (size_t)(tok - (in ? j : 0)) * PW + c8);
            const float f[8] = {bf_lo(v[0]), bf_hi(v[0]), bf_lo(v[1]), bf_hi(v[1]), bf_lo(v[2]), bf_hi(v[2]), bf_lo(v[3]), bf_hi(v[3])};
#pragma unroll
            for (int e = 0; e < 8; ++e) { s[e] += in ? f[e] : 0.f; if (j == 0) u0[e] = f[e]; }
        }
        const float inv = 1.0f / (float)cnt;
        u32x4 o;
        o[0] = cvt_pk_bf16(s[0] * inv - u0[0], s[1] * inv - u0[1]); o[1] = cvt_pk_bf16(s[2] * inv - u0[2], s[3] * inv - u0[3]);
        o[2] = cvt_pk_bf16(s[4] * inv - u0[4], s[5] * inv - u0[5]); o[3] = cvt_pk_bf16(s[6] * inv - u0[6], s[7] * inv - u0[7]);
        *(u32x4*)(P1 + (size_t)tok * PW + c8) = o;
    }
}
__device__ __forceinline__ void pool_pass(const bf16_t* __restrict__ U, bf16_t* __restrict__ P1) {
    pool_group<2>(U, P1, 0); pool_group<4>(U, P1, 1); pool_group<8>(U, P1, 2); pool_group<16>(U, P1, 3);
}

__device__ __forceinline__ void conv_fixup(const float* __restrict__ halo, const float* __restrict__ cw, const float* __restrict__ cb, bf16_t* __restrict__ act) {
    const int nthr = gridDim.x * 512, nq = DFF / 4;
    for (int it = blockIdx.x * 512 + tidx(); it < 512 * nq; it += nthr) {
        const int ri = it / nq, ch = (it % nq) * 4, blk = ri >> 1, i = ri & 1;
        const bool first = (blk & 63) == 0;
        f32x4 res[2];
#pragma unroll
        for (int bj = 0; bj < 2; ++bj) {
            const int cc = bj * DFF + ch;
            const f32x4 z = (f32x4){0.f, 0.f, 0.f, 0.f};
            const f32x4 cur = *(const f32x4*)(halo + (size_t)(blk * 4 + i) * UPW + cc);
            f32x4 p1, p2;
            if (i == 0) { p1 = first ? z : *(const f32x4*)(halo + (size_t)((blk - 1) * 4 + 3) * UPW + cc); p2 = first ? z : *(const f32x4*)(halo + (size_t)((blk - 1) * 4 + 2) * UPW + cc); }
            else { p1 = *(const f32x4*)(halo + (size_t)(blk * 4 + 0) * UPW + cc); p2 = first ? z : *(const f32x4*)(halo + (size_t)((blk - 1) * 4 + 3) * UPW + cc); }
            res[bj] = *(const f32x4*)(cb + cc) + *(const f32x4*)(cw + 2 * UPW + cc) * cur + *(const f32x4*)(cw + UPW + cc) * p1 + *(const f32x4*)(cw + cc) * p2;
        }
        u32x2 o; o[0] = cvt_pk_bf16(gelu_mul(res[0][0], res[1][0]), gelu_mul(res[0][1], res[1][1])); o[1] = cvt_pk_bf16(gelu_mul(res[0][2], res[1][2]), gelu_mul(res[0][3], res[1][3]));
        *(u32x2*)(act + (size_t)(blk * 64 + i) * DFF + ch) = o;
    }
}

__device__ __forceinline__ void k_load(bf16x8 (&k)[8], const bf16_t* kbase, int kt) {
    const bf16_t* kp = kbase + (size_t)kt * 32 * AW;
#pragma unroll
    for (int kk = 0; kk < 8; ++kk) k[kk] = *(const bf16x8*)(kp + 16 * kk);
}
__device__ __forceinline__ void v_load(bf16x8 (&v)[8], const bf16_t* vbase, int kt) {
    const bf16_t* vp = vbase + kt * 32;
#pragma unroll
    for (int d = 0; d < 4; ++d)
#pragma unroll
        for (int s = 0; s < 2; ++s) v[d * 2 + s] = *(const bf16x8*)(vp + (size_t)d * 32 * MTOK + 16 * s);
}
__device__ __forceinline__ void attn_item(const bf16_t* __restrict__ Q, const bf16_t* __restrict__ Kp, const bf16_t* __restrict__ Vt, bf16_t* __restrict__ AO, int b, int hd, int qblk, int lane) {
    const int r = lane & 31, h = lane >> 5;
    const int pr = (r & ~12) | ((r & 4) << 1) | ((r & 8) >> 1);
    const size_t tok0 = (size_t)b * SEQ + (size_t)qblk * 32;
    bf16x8 qf[8];
    const bf16_t* qp = Q + (tok0 + r) * AW + hd * 128 + 8 * h;
#pragma unroll
    for (int kk = 0; kk < 8; ++kk) qf[kk] = *(const bf16x8*)(qp + 16 * kk);
    f32x16 o[4];
#pragma unroll
    for (int d = 0; d < 4; ++d)
#pragma unroll
        for (int i = 0; i < 16; ++i) o[d][i] = 0.f;
    float carry = 0.f;
    const bf16_t* kbase = Kp + ((size_t)b * SEQ + pr) * AW + hd * 128 + 8 * h;
    const bf16_t* vbase = Vt + (size_t)(hd * 128 + r) * MTOK + (size_t)b * SEQ + 8 * h;
    bf16x8 kf[8], vf[8];
    k_load(kf, kbase, qblk);
    for (int kt = qblk; kt >= 0; --kt) {
        const bool diag = (kt == qblk);
        v_load(vf, vbase, kt);
        f32x16 s;
#pragma unroll
        for (int i = 0; i < 16; ++i) s[i] = 0.f;
#pragma unroll
        for (int kk = 0; kk < 8; ++kk) s = __builtin_amdgcn_mfma_f32_32x32x16_bf16(kf[kk], qf[kk], s, 0, 0, 0);
        if (kt > 0) k_load(kf, kbase, kt - 1);
        float T0 = 0.f, T1 = 0.f;
        float lm[16];
#pragma unroll
        for (int i = 0; i < 16; ++i) {
            const float y = s[i];
            const float e = __builtin_amdgcn_exp2f(-__builtin_fabsf(y));
            const float tt = __builtin_amdgcn_logf(1.0f + e);
            float lsv = fminf(y, 0.f) - tt;
            float lmv = lsv - y;
            if (diag) { const bool valid = (16 * (i >> 3) + 8 * h + (i & 7)) < r; lmv = valid ? lmv : 0.f; lsv = valid ? lsv : -1e30f; }
            s[i] = lsv; lm[i] = lmv;
            if (i < 8) T0 += lmv; else T1 += lmv;
        }
        const float OT0 = __shfl_xor(T0, 32), OT1 = __shfl_xor(T1, 32);
        const float after0 = (h == 0 ? OT0 : 0.f) + T1 + OT1, after1 = (h == 0 ? OT1 : 0.f);
        {
            float run = after0 + carry;
#pragma unroll
            for (int j = 7; j >= 0; --j) { s[j] = __builtin_amdgcn_exp2f(s[j] + run); run += lm[j]; }
            run = after1 + carry;
#pragma unroll
            for (int j = 7; j >= 0; --j) { s[8 + j] = __builtin_amdgcn_exp2f(s[8 + j] + run); run += lm[8 + j]; }
        }
        carry += (T0 + T1) + (OT0 + OT1);
        bf16x8 pf[2];
#pragma unroll
        for (int sI = 0; sI < 2; ++sI) {
            u32x4 w; w[0] = cvt_pk_bf16(s[8 * sI + 0], s[8 * sI + 1]); w[1] = cvt_pk_bf16(s[8 * sI + 2], s[8 * sI + 3]); w[2] = cvt_pk_bf16(s[8 * sI + 4], s[8 * sI + 5]); w[3] = cvt_pk_bf16(s[8 * sI + 6], s[8 * sI + 7]);
            pf[sI] = __builtin_bit_cast(bf16x8, w);
        }
#pragma unroll
        for (int d = 0; d < 4; ++d)
#pragma unroll
            for (int sI = 0; sI < 2; ++sI) o[d] = __builtin_amdgcn_mfma_f32_32x32x16_bf16(vf[d * 2 + sI], pf[sI], o[d], 0, 0, 0);
        if (__builtin_amdgcn_ballot_w64(carry > -150.0f) == 0ull) break;
    }
    bf16_t* op = AO + (tok0 + r) * AW + hd * 128 + 4 * h;
#pragma unroll
    for (int d = 0; d < 4; ++d)
#pragma unroll
        for (int j = 0; j < 4; ++j) { u32x2 w; w[0] = cvt_pk_bf16(o[d][4 * j + 0], o[d][4 * j + 1]); w[1] = cvt_pk_bf16(o[d][4 * j + 2], o[d][4 * j + 3]); *(u32x2*)(op + d * 32 + 8 * j) = w; }
}
__device__ __forceinline__ void attn_phase(const bf16_t* Q, const bf16_t* Kp, const bf16_t* Vt, bf16_t* AO) {
    const int lane = tidx() & 63, w = tidx() >> 6;
    for (int g = blockIdx.x; g < 256; g += gridDim.x) {
        const int xcd = g & 7, idx = g >> 3, bh = xcd * 4 + (idx >> 3), sub = idx & 7, x = sub * 8 + w;
        const int b = bh >> 3, hd = bh & 7;
        attn_item(Q, Kp, Vt, AO, b, hd, 127 - x, lane);
        attn_item(Q, Kp, Vt, AO, b, hd, x, lane);
    }
}

#ifndef FUSE_OUT
#define FUSE_OUT 1
#endif
#ifndef N_LAUNCH_MODE
#define N_LAUNCH_MODE 1
#endif
constexpr int NPHASE = 13;
template <int ph> __device__ __forceinline__ void run_phase(const Params& p, unsigned char* shm) {
    LAS unsigned char* lds = (LAS unsigned char*)shm;
    unsigned char* ws = p.ws;
    {
        if constexpr (ph == 0) {
            float* tile = (float*)shm;
            cvt_transpose(p.in[3], (bf16_t*)(ws + WS_WIN), DM, 8192, DM, 1, tile);
            cvt_transpose(p.in[4], (bf16_t*)(ws + WS_WAB), AW, DM, AW, 0, tile);
            cvt_transpose(p.in[5], (bf16_t*)(ws + WS_WPG), 1024, 256, 1024, 0, tile);
            cvt_transpose(p.in[7], (bf16_t*)(ws + WS_WPB), PW, DM, PW, 0, tile);
            cvt_transpose(p.in[8], (bf16_t*)(ws + WS_WOUT), DM, DM, DM, 0, tile);
            cvt_transpose(p.in[11], (bf16_t*)(ws + WS_WUP), DM, UPW, DM, 2, tile);
            cvt_transpose(p.in[14], (bf16_t*)(ws + WS_WDN), DFF, DM, DFF, 0, tile);
            cvt_transpose(p.in[16], (bf16_t*)(ws + WS_WPLE), PLE, DM, PLE, 0, tile);
            cvt_transpose(p.in[17], (bf16_t*)(ws + WS_WPGATE), DM, DM, DM, 0, tile);
            #if FUSE_OUT
            x_pass(p.in[0], (bf16_t*)p.out + (size_t)MTOK * DM, p.in[2], (bf16_t*)(ws + WS_H));
#else
            row_pass<false, 0, true>(nullptr, p.in[0], nullptr, nullptr, p.in[2], (bf16_t*)(ws + WS_H));
#endif
            {
                const float4* src = (const float4*)p.in[1]; u32x2* dst = (u32x2*)(ws + WS_PB);
                for (int i = blockIdx.x * 512 + tidx(); i < MTOK * PLE / 4; i += gridDim.x * 512) { const float4 v = src[i]; u32x2 o; o[0] = cvt_pk_bf16(v.x, v.y); o[1] = cvt_pk_bf16(v.z, v.w); dst[i] = o; }
            }
        } else if constexpr (ph == 1) {
            Epi<EPI_PROJ> e{}; e.ws = ws; e.qscale = 0.08838834764831845f * LOG2E;
            run_gemm(lds, (const bf16_t*)(ws + WS_H), DM, (const bf16_t*)(ws + WS_WIN), DM, MTOK, 7168, DM, e);
            Epi<EPI_PLAIN> ev{}; ev.O = (bf16_t*)(ws + WS_VT); ev.ldc = MTOK; ev.cs = nullptr;
            run_gemm(lds, (const bf16_t*)(ws + WS_WIN) + (size_t)7168 * DM, DM, (const bf16_t*)(ws + WS_H), DM, AW, MTOK, DM, ev);
        } else if constexpr (ph == 2) {
            pool_pass((const bf16_t*)(ws + WS_U), (bf16_t*)(ws + WS_P1));
            attn_phase((const bf16_t*)(ws + WS_Q), (const bf16_t*)(ws + WS_K), (const bf16_t*)(ws + WS_VT), (bf16_t*)(ws + WS_AO));
        } else if constexpr (ph == 3) {
            Epi<EPI_GATE1> e{}; e.O = (bf16_t*)(ws + WS_TMP); e.ldc = DM; e.X1 = (const bf16_t*)(ws + WS_GA); e.ldx = DM;
            run_gemm(lds, (const bf16_t*)(ws + WS_AO), AW, (const bf16_t*)(ws + WS_WAB), AW, MTOK, DM, AW, e);
            for (int gi = 0; gi < 4; ++gi) {
                Epi<EPI_PLAIN> eg{}; eg.O = (bf16_t*)(ws + WS_P2) + gi * 256; eg.ldc = PW; eg.cs = p.in[6] + gi * 256;
                run_gemm(lds, (const bf16_t*)(ws + WS_P1) + gi * 256, PW, (const bf16_t*)(ws + WS_WPG) + gi * 256, 1024, MTOK, 256, 256, eg, gi * 64);
            }
        } else if constexpr (ph == 4) {
            Epi<EPI_GATE2> e{}; e.O = (bf16_t*)(ws + WS_MIXED); e.ldc = DM; e.X1 = (const bf16_t*)(ws + WS_GP); e.X2 = (const bf16_t*)(ws + WS_TMP); e.ldx = DM;
            run_gemm(lds, (const bf16_t*)(ws + WS_P2), PW, (const bf16_t*)(ws + WS_WPB), PW, MTOK, DM, PW, e);
        } else if constexpr (ph == 5) {
#if FUSE_OUT
            Epi<EPI_OUTF> e{}; e.ldsp = lds;
            run_gemm_panel(lds, (const bf16_t*)(ws + WS_MIXED), DM, (const bf16_t*)(ws + WS_WOUT), DM, MTOK, DM, DM, e);
#else
            Epi<EPI_PLAIN> e{}; e.O = (bf16_t*)(ws + WS_Y); e.ldc = DM; e.cs = nullptr;
            run_gemm(lds, (const bf16_t*)(ws + WS_MIXED), DM, (const bf16_t*)(ws + WS_WOUT), DM, MTOK, DM, DM, e);
#endif
        } else if constexpr (ph == 6) {
            #if !FUSE_OUT
            row_pass<false, 2, true>((const bf16_t*)(ws + WS_Y), p.in[0], p.in[9], p.out, p.in[10], (bf16_t*)(ws + WS_H));
#endif
        } else if constexpr (ph == 7) {
            Epi<EPI_UP> e{}; e.ldsp = lds; e.O = (bf16_t*)(ws + WS_ACT); e.cs = p.in[12]; e.cb = p.in[13]; e.halo = (float*)(ws + WS_HALO);
            run_gemm(lds, (const bf16_t*)(ws + WS_H), DM, (const bf16_t*)(ws + WS_WUP), DM, MTOK, UPW, DM, e);
        } else if constexpr (ph == 8) {
            conv_fixup((const float*)(ws + WS_HALO), p.in[12], p.in[13], (bf16_t*)(ws + WS_ACT));
        } else if constexpr (ph == 9) {
            Epi<EPI_DOWNF> e{}; e.ldsp = lds; e.O = (bf16_t*)(ws + WS_H); e.ldc = DM; e.X2 = (const bf16_t*)p.out; e.ldx = DM; e.cs = p.in[15];
            e.xch = (float*)(ws + WS_XCH) + 3 * 64 * 8 * 256; e.cnt = (unsigned*)(ws + WS_BAR) + XCNT_WORD0 + 3 * 64 * 64;
            run_gemm_panel(lds, (const bf16_t*)(ws + WS_ACT), DFF, (const bf16_t*)(ws + WS_WDN), DFF, MTOK, DM, DFF, e);
        } else if constexpr (ph == 10) {
        } else if constexpr (ph == 11) {
            Epi<EPI_PLAIN> e{}; e.O = (bf16_t*)(ws + WS_E); e.ldc = DM; e.cs = nullptr;
            run_gemm_panel(lds, (const bf16_t*)(ws + WS_PB), PLE, (const bf16_t*)(ws + WS_WPLE), PLE, MTOK, DM, PLE, e);
            Epi<EPI_PLEF> e2{}; e2.ldsp = lds; e2.X1 = (const bf16_t*)(ws + WS_E); e2.X2 = (const bf16_t*)(ws + WS_H); e2.ldx = DM; e2.cs = p.in[18];
            e2.xch = (float*)(ws + WS_XCH); e2.cnt = (unsigned*)(ws + WS_BAR) + XCNT_WORD0; e2.Of = p.out;
            run_gemm_panel(lds, (const bf16_t*)(ws + WS_H), DM, (const bf16_t*)(ws + WS_WPGATE), DM, MTOK, DM, DM, e2);
        } else if constexpr (ph == 12) {
        }
    }
}


template <int PH> __global__ __launch_bounds__(512, 2) void k_phase(Params p) {
    extern __shared__ __attribute__((aligned(16))) unsigned char shm[];
    run_phase<PH>(p, shm);
}
#if N_LAUNCH_MODE >= 1
#define XB_TMO      128
#define XB_XCNT(j)  (256  + 64 * (j))
#define XB_XSUB(j)  (1280 + 64 * (j))
#define XB_XGEN(j)  (2304 + 64 * (j))
#define XB_TOP      3328
#define XB_TOPGEN   3392
#define XCD_BAR_WORDS 3456
#define XB_SPIN_CAP (1u << 18)
__device__ __forceinline__ unsigned xb_ld(unsigned* p)              { return __hip_atomic_load(p, __ATOMIC_RELAXED, __HIP_MEMORY_SCOPE_AGENT); }
__device__ __forceinline__ unsigned xb_add(unsigned* p, unsigned v) { return __hip_atomic_fetch_add(p, v, __ATOMIC_RELAXED, __HIP_MEMORY_SCOPE_AGENT); }
__device__ __forceinline__ unsigned xb_xcc_id() { return (unsigned)__builtin_amdgcn_s_getreg((3 << 11) | 20) & 0xFu; }
#define XB_SPIN(cond, bar) do { unsigned _sp = 0; while (cond) { __builtin_amdgcn_s_sleep(1); \
    if ((++_sp & 255u) == 0u) { if (xb_ld(&(bar)[XB_TMO])) break; if (_sp > XB_SPIN_CAP) { atomicAdd(&(bar)[XB_TMO], 1u); break; } } } } while (0)
__device__ __forceinline__ void xcd_barrier_complete(unsigned* bar, unsigned x, unsigned& nloc, unsigned& nx) {
    const unsigned G = gridDim.x;
    unsigned sum, cnt, mine, sp = 0u;
    for (;;) {
        sum = 0u; cnt = 0u; mine = 0u;
#pragma unroll
        for (unsigned j = 0; j < 16; ++j) { const unsigned c = xb_ld(&bar[XB_XCNT(j)]); sum += c; cnt += (c > 0u) ? 1u : 0u; mine = (j == x) ? c : mine; }
        if (sum == G) break;
        __builtin_amdgcn_s_sleep(1);
        if ((++sp & 255u) == 0u) { if (xb_ld(&bar[XB_TMO])) break; if (sp > XB_SPIN_CAP) { atomicAdd(&bar[XB_TMO], 1u); break; } }
    }
    nloc = mine > 0u ? mine : 1u; nx = cnt > 0u ? cnt : 1u;
}
__device__ __forceinline__ void xcd_barrier(unsigned* bar, volatile LAS unsigned* st) {
    asm volatile("s_waitcnt vmcnt(0) lgkmcnt(0)" ::: "memory");
    __syncthreads();
    if (tidx() == 0) {
        const unsigned x = xb_xcc_id();
        unsigned nloc = st[0], nx = st[1];
        if (nloc == 0u) { xcd_barrier_complete(bar, x, nloc, nx); st[0] = nloc; st[1] = nx; }
        const unsigned old = xb_add(&bar[XB_XSUB(x)], 1u);
        const unsigned gen = old / nloc;
        if (old + 1u == (gen + 1u) * nloc) {
            __builtin_amdgcn_fence(__ATOMIC_RELEASE, "agent");
            asm volatile("s_waitcnt vmcnt(0)" ::: "memory");
            const unsigned og = xb_add(&bar[XB_TOP], 1u);
            const unsigned tg = og / nx;
            if (og + 1u == (tg + 1u) * nx) xb_add(&bar[XB_TOPGEN], 1u);
            else XB_SPIN(xb_ld(&bar[XB_TOPGEN]) == tg, bar);
            __builtin_amdgcn_fence(__ATOMIC_ACQUIRE, "agent");
            xb_add(&bar[XB_XGEN(x)], 1u);
            asm volatile("s_waitcnt vmcnt(0)" ::: "memory");
        } else {
            XB_SPIN(xb_ld(&bar[XB_XGEN(x)]) == gen, bar);
            __builtin_amdgcn_fence(__ATOMIC_ACQUIRE, "agent");
            asm volatile("s_waitcnt vmcnt(0)" ::: "memory");
        }
    }
    __syncthreads();
}
typedef const __attribute__((address_space(4))) Params* KargPtr;
#if defined(__HIP_DEVICE_COMPILE__)
#define RUNPH(N) do { KargPtr q = pp; asm volatile("" : "+s"(q)); Params pl; __builtin_memcpy(&pl, q, sizeof(Params)); if (N >= pl.ph_lo && N < pl.ph_hi) { run_phase<N>(pl, shm); if (N + 1 < pl.ph_hi) GSYNC(); } } while (0)
#else
#define RUNPH(N) do { } while (0)
#endif
__global__ __launch_bounds__(512, 2) void mega(Params p_unused) {
    extern __shared__ __attribute__((aligned(16))) unsigned char shm[];
    cg::grid_group grid = cg::this_grid();
    KargPtr pp = (KargPtr)__builtin_amdgcn_kernarg_segment_ptr();
    volatile LAS unsigned* xst = (volatile LAS unsigned*)((LAS unsigned char*)shm + STAGE_BYTES);
    if (tidx() == 0) { xst[0] = 0u; xst[1] = 0u; (void)xb_add(&((unsigned*)(pp->ws + WS_BAR))[XB_XCNT(xb_xcc_id())], 1u); }
    __syncthreads();
    if (pp->ph_lo < 0) grid.sync();
#define GSYNC() do { KargPtr qb = pp; asm volatile("" : "+s"(qb)); xcd_barrier((unsigned*)(qb->ws + WS_BAR), xst); } while (0)
    RUNPH(0);
    RUNPH(1);
    RUNPH(2);
    RUNPH(3);
    RUNPH(4);
    RUNPH(5);
#if !FUSE_OUT
    RUNPH(6);
#endif
    RUNPH(7);
    RUNPH(8);
    RUNPH(9);
    RUNPH(11);
}
#endif
template <int PH> static void launch_phase(const Params& p, int grid, hipStream_t stream) {
    (void)hipFuncSetAttribute((const void*)k_phase<PH>, hipFuncAttributeMaxDynamicSharedMemorySize, STAGE_BYTES);
    hipLaunchKernelGGL(k_phase<PH>, dim3(grid), dim3(512), STAGE_BYTES, stream, p);
}
extern "C" void kernel_launch(void* const* d_in, const int* in_sizes, int n_in, void* d_out, int out_size, void* d_ws, size_t ws_size, hipStream_t stream) {
    static int grid = 0;
    if (grid == 0) {
        int dev = 0, cus = 0, per_cu = 0;
        (void)hipGetDevice(&dev);
        (void)hipDeviceGetAttribute(&cus, hipDeviceAttributeMultiprocessorCount, dev);
#if N_LAUNCH_MODE >= 1
        (void)hipFuncSetAttribute((const void*)mega, hipFuncAttributeMaxDynamicSharedMemorySize, LDS_BYTES);
        (void)hipOccupancyMaxActiveBlocksPerMultiprocessor(&per_cu, (const void*)mega, 512, LDS_BYTES);
#endif
        if (per_cu < 1) per_cu = 1;
        grid = cus * per_cu;
        if (grid > 256) grid = 256;
        if (n_in != 19 || ws_size < 484 * MiB) { fprintf(stderr, "kernel_launch: unexpected n_in %d / ws_size %zu\n", n_in, ws_size); }
    }
    Params p{};
    for (int i = 0; i < 19; ++i) p.in[i] = (const float*)d_in[i];
    p.out = (float*)d_out; p.ws = (unsigned char*)d_ws;
    p.ph_lo = 0; p.ph_hi = 12;
#if N_LAUNCH_MODE == 1
    (void)hipMemsetAsync((unsigned char*)d_ws + WS_BAR, 0, 131072, stream);
    void* args[] = {&p};
    hipError_t e = hipLaunchCooperativeKernel((const void*)mega, dim3(grid), dim3(512), args, LDS_BYTES, stream);
    if (e != hipSuccess) fprintf(stderr, "cooperative launch failed: %s (grid %d)\n", hipGetErrorString(e), grid);
#elif N_LAUNCH_MODE == 2
#ifndef BISECT_X
#define BISECT_X 2
#endif
#define LP(N) do { if (N < BISECT_X) launch_phase<N>(p, grid, stream); else { p.ph_lo = N; p.ph_hi = N + 1; hipLaunchKernelGGL(mega, dim3(grid), dim3(512), LDS_BYTES, stream, p); } } while (0)
    LP(0); LP(1); LP(2); LP(3); LP(4); LP(5); LP(6); LP(7); LP(8); LP(9); LP(10); LP(11); LP(12);
#else
    launch_phase<0>(p, grid, stream); launch_phase<1>(p, grid, stream); launch_phase<2>(p, grid, stream); launch_phase<3>(p, grid, stream);
    launch_phase<4>(p, grid, stream); launch_phase<5>(p, grid, stream); launch_phase<6>(p, grid, stream); launch_phase<7>(p, grid, stream);
    launch_phase<8>(p, grid, stream); launch_phase<9>(p, grid, stream); launch_phase<10>(p, grid, stream); launch_phase<11>(p, grid, stream);
    launch_phase<12>(p, grid, stream);
#endif
}
```

```cpp
#include <hip/hip_runtime.h>
#include <hip/hip_cooperative_groups.h>
#include <cstdio>
namespace cg = cooperative_groups;

#define LAS __attribute__((address_space(3)))
typedef unsigned short bf16_t;
typedef short bf16x8 __attribute__((ext_vector_type(8)));
typedef float f32x4 __attribute__((ext_vector_type(4)));
typedef float f32x16 __attribute__((ext_vector_type(16)));
typedef unsigned u32x4 __attribute__((ext_vector_type(4)));
typedef unsigned u32x2 __attribute__((ext_vector_type(2)));

constexpr int MTOK = 16384, DM = 2048, SEQ = 4096, AW = 1024, PW = 1024, DFF = 5632, UPW = 11264, PLE = 256;
constexpr float EPS = 1e-6f;
constexpr float LOG2E = 1.4426950408889634f;
constexpr size_t MiB = 1048576;
constexpr size_t WS_WIN = 0, WS_WAB = 32 * MiB, WS_WPG = 36 * MiB, WS_WPB = 37 * MiB, WS_WOUT = 41 * MiB, WS_WUP = 49 * MiB, WS_WDN = 93 * MiB, WS_WPLE = 115 * MiB, WS_WPGATE = 116 * MiB;
constexpr size_t WS_Q = 124 * MiB, WS_K = 156 * MiB, WS_U = 188 * MiB, WS_VT = 220 * MiB, WS_GA = 252 * MiB, WS_GP = 316 * MiB;
constexpr size_t WS_H = 380 * MiB, WS_AO = 380 * MiB, WS_P2 = 412 * MiB, WS_P1 = 444 * MiB, WS_PB = 476 * MiB;
constexpr size_t WS_BAR = 500 * MiB, WS_XCH = 501 * MiB;
constexpr int XCNT_WORD0 = 4096;
constexpr size_t WS_MIXED = 124 * MiB, WS_TMP = 188 * MiB, WS_Y = 188 * MiB, WS_ACT = 124 * MiB, WS_HALO = 300 * MiB, WS_X2B = 124 * MiB, WS_E = 188 * MiB, WS_Z = 252 * MiB;

struct Params { const float* in[19]; float* out; unsigned char* ws; int ph_lo, ph_hi; };

__device__ __forceinline__ int tidx() { int t = (int)__builtin_amdgcn_workitem_id_x(); asm volatile("" : "+v"(t)); return t; }
typedef __bf16 bf16x2_t __attribute__((ext_vector_type(2)));
typedef float f32x2_t __attribute__((ext_vector_type(2)));
__device__ __forceinline__ unsigned cvt_pk_bf16(float lo, float hi) { const f32x2_t v = {lo, hi}; return __builtin_bit_cast(unsigned, __builtin_convertvector(v, bf16x2_t)); }
__device__ __forceinline__ float bf_lo(unsigned w) { return __uint_as_float(w << 16); }
__device__ __forceinline__ float bf_hi(unsigned w) { return __uint_as_float(w & 0xffff0000u); }
__device__ __forceinline__ float sigmoidf_(float x) { return __builtin_amdgcn_rcpf(1.0f + __builtin_amdgcn_exp2f(-LOG2E * x)); }
__device__ __forceinline__ float wave_sum(float v) {
#pragma unroll
    for (int o = 32; o; o >>= 1) v += __shfl_xor(v, o);
    return v;
}
__device__ __forceinline__ float dpp_ror1(float x) { return __int_as_float(__builtin_amdgcn_mov_dpp(__float_as_int(x), 0x121, 0xF, 0xF, false)); }
__device__ __forceinline__ float dpp_ror2(float x) { return __int_as_float(__builtin_amdgcn_mov_dpp(__float_as_int(x), 0x122, 0xF, 0xF, false)); }
__device__ __forceinline__ float dpp_shr1(float x) { return __int_as_float(__builtin_amdgcn_update_dpp(0, __float_as_int(x), 0x111, 0xF, 0xF, true)); }
__device__ __forceinline__ f32x4 shr1v(f32x4 x) { return (f32x4){dpp_shr1(x[0]), dpp_shr1(x[1]), dpp_shr1(x[2]), dpp_shr1(x[3])}; }
__device__ __forceinline__ f32x4 ror1v(f32x4 x) { return (f32x4){dpp_ror1(x[0]), dpp_ror1(x[1]), dpp_ror1(x[2]), dpp_ror1(x[3])}; }
__device__ __forceinline__ f32x4 ror2v(f32x4 x) { return (f32x4){dpp_ror2(x[0]), dpp_ror2(x[1]), dpp_ror2(x[2]), dpp_ror2(x[3])}; }
__device__ __forceinline__ float gelu_mul(float g, float v) {
    const float u = g * (0.7978845608f + 0.0356774081f * g * g);
    return g * v * __builtin_amdgcn_rcpf(1.0f + __builtin_amdgcn_exp2f(-2.0f * LOG2E * u));
}

constexpr int BM = 256, BK = 64, HALF = 128, HTB = HALF * BK * 2, STAGE_BYTES = 8 * HTB, CW_OFF = STAGE_BYTES + 1024  , LDS_BYTES = CW_OFF + 8192, NXCD = 8, WGM = 8;
__host__ __device__ __forceinline__ int lds_byte(int r, int c) { const int st = (r >> 4) * 2 + (c >> 5), rr = r & 15, cc = c & 31, ob = rr * 64 + cc * 2; return st * 1024 + (ob ^ (((ob >> 9) & 1) << 5)); }
__host__ __device__ __forceinline__ void stage_rc(int b, int& R, int& C) { const int st = b / 1024, sb = b % 1024, swz = sb ^ (((sb >> 9) & 1) << 5); R = (st >> 1) * 16 + swz / 64; C = (st & 1) * 32 + (swz % 64) / 2; }
__host__ __device__ __forceinline__ int perm32(int rho) { const int n = rho >> 4, i = rho & 15; return 8 * (i >> 2) + 4 * n + (i & 3); }

struct Unit { int pm, pn; };
struct Gemm { const bf16_t* A; const bf16_t* Bt; int M, N, K, lda, ldb; };
struct StaticOrder {
    int nM, nN, nwg, G, c;
    __device__ void init(int M, int N, int G_, int c_) { nM = M / BM; nN = N / BM; nwg = nM * nN; G = G_; c = c_; }
    __device__ bool next(int i, Unit& u) const {
        const long L = (long)i * G + c; if (L >= nwg) return false;
        int wgid = (int)L; { const int q = nwg / NXCD, r = nwg % NXCD, xcd = wgid % NXCD, off = wgid / NXCD; wgid = (xcd < r ? xcd * (q + 1) : r * (q + 1) + (xcd - r) * q) + off; }
        const int nig = WGM * nN, gid = wgid / nig, fm = gid * WGM, gsz = (nM - fm) < WGM ? (nM - fm) : WGM;
        u.pm = fm + ((wgid % nig) % gsz); u.pn = (wgid % nig) / gsz; return true;
    }
};

struct PanelOrder {
    int nwg, G, c;
    __device__ void init(int M, int N, int G_, int c_) { nwg = (M / BM) * (N / BM); G = G_; c = c_; }
    __device__ bool next(int i, Unit& u) const {
        if (i * G + c >= nwg) return false;
        const int x = c & 7, rank = c >> 3;
        u.pm = i * 32 + 4 * x + (rank & 3); u.pn = rank >> 2; return true;
    }
};
enum { EPI_PROJ = 0, EPI_PLAIN = 1, EPI_GATE1 = 2, EPI_GATE2 = 3, EPI_UP = 4, EPI_PLE = 5, EPI_PLEF = 6, EPI_DOWNF = 7, EPI_OUTF = 8 };
__device__ __forceinline__ void row_rs_exchange(const f32x4 (&acc)[2][2][4][2], const Unit& u, int wr, int wc, int fr, int fq, LAS unsigned char* ldsp, float* xch, unsigned* cnt) {
    const int tid = tidx();
    LAS float* part = (LAS float*)(ldsp + CW_OFF);
    LAS float* rsv = (LAS float*)(ldsp + CW_OFF + 4096);
#pragma unroll
    for (int ai = 0; ai < 2; ++ai)
#pragma unroll
        for (int m = 0; m < 4; ++m) {
            float ps = 0.f;
#pragma unroll
            for (int bj = 0; bj < 2; ++bj)
#pragma unroll
                for (int n = 0; n < 2; ++n)
#pragma unroll
                    for (int k = 0; k < 4; ++k) ps += acc[ai][bj][m][n][k] * acc[ai][bj][m][n][k];
            ps += __shfl_xor(ps, 16); ps += __shfl_xor(ps, 32);
            if (fq == 0) part[(ai * HALF + wr * 64 + m * 16 + fr) * 4 + wc] = ps;
        }
    __syncthreads();
    if (tid < 256) {
        const float sp = (part[tid * 4 + 0] + part[tid * 4 + 1]) + (part[tid * 4 + 2] + part[tid * 4 + 3]);
        __hip_atomic_store(xch + ((size_t)(u.pm * 8 + u.pn) * 256 + tid), sp, __ATOMIC_RELAXED, __HIP_MEMORY_SCOPE_AGENT);
    }
    asm volatile("s_waitcnt vmcnt(0)" ::: "memory");
    __syncthreads();
    if (tid == 0) {
        unsigned* cp = cnt + u.pm * 64;
        __hip_atomic_fetch_add(cp, 1u, __ATOMIC_RELAXED, __HIP_MEMORY_SCOPE_AGENT);
        unsigned sp = 0;
        while (__hip_atomic_load(cp, __ATOMIC_RELAXED, __HIP_MEMORY_SCOPE_AGENT) < 8u) { __builtin_amdgcn_s_sleep(1); if (++sp > (1u << 20)) break; }
    }
    __syncthreads();
    if (tid < 256) {
        float tot = 0.f;
#pragma unroll
        for (int j = 0; j < 8; ++j) tot += __hip_atomic_load(xch + ((size_t)(u.pm * 8 + j) * 256 + tid), __ATOMIC_RELAXED, __HIP_MEMORY_SCOPE_AGENT);
        rsv[tid] = rsqrtf(tot * (1.0f / DM) + EPS);
    }
    __syncthreads();
}
template <int MODE> struct Epi {
    static constexpr bool PERMA = (MODE == EPI_UP);
    static constexpr bool PREFETCH = (MODE == EPI_UP);
    LAS unsigned char* ldsp;
    __device__ __forceinline__ void prefetch(const Unit& u, int wid, int lane) const {
        if constexpr (MODE == EPI_UP) {
            const int seg = lane >> 3, tab = seg >> 1, bj = seg & 1;
            const float* src = (tab < 3 ? cs + tab * UPW : cb) + bj * DFF + u.pn * 128 + (wid & 3) * 32 + (lane & 7) * 4;
            __builtin_amdgcn_global_load_lds((const unsigned*)src, (LAS unsigned*)(ldsp + CW_OFF + wid * 1024), 16, 0, 0);
        }
    }
    bf16_t* O; int ldc;
    const bf16_t* X1; const bf16_t* X2; int ldx;
    const float* cs; const float* cb; float* halo; unsigned char* ws; float qscale;
    float* xch; unsigned* cnt; float* Of; const float* Xf; bf16_t* Ob;
    __device__ __forceinline__ void operator()(f32x4 (&acc)[2][2][4][2], const Unit& u, int wr, int wc, int fr, int fq) const {
        int row0 = u.pm * BM + wr * 64 + fr;
        int colb = u.pn * BM + wc * 32 + 8 * fq;
        asm volatile("" : "+v"(row0), "+v"(colb));
        if constexpr (MODE == EPI_PLEF) {
            if (wr == 0) __builtin_amdgcn_s_barrier();
#pragma unroll
            for (int bj = 0; bj < 2; ++bj) {
                const int c = colb + bj * HALF;
#pragma unroll
                for (int ai = 0; ai < 2; ++ai)
#pragma unroll
                    for (int m = 0; m < 4; ++m) {
                        const int r = row0 + ai * HALF + m * 16;
                        const u32x4 e = *(const u32x4*)(X1 + (size_t)r * ldx + c);
                        f32x4& v0 = acc[ai][bj][m][0]; f32x4& v1 = acc[ai][bj][m][1];
                        v0[0] = sigmoidf_(v0[0]) * bf_lo(e[0]); v0[1] = sigmoidf_(v0[1]) * bf_hi(e[0]); v0[2] = sigmoidf_(v0[2]) * bf_lo(e[1]); v0[3] = sigmoidf_(v0[3]) * bf_hi(e[1]);
                        v1[0] = sigmoidf_(v1[0]) * bf_lo(e[2]); v1[1] = sigmoidf_(v1[1]) * bf_hi(e[2]); v1[2] = sigmoidf_(v1[2]) * bf_lo(e[3]); v1[3] = sigmoidf_(v1[3]) * bf_hi(e[3]);
                    }
            }
            row_rs_exchange(acc, u, wr, wc, fr, fq, ldsp, xch, cnt);
            LAS float* rsv = (LAS float*)(ldsp + CW_OFF + 4096);
#pragma unroll
            for (int bj = 0; bj < 2; ++bj) {
                const int c = colb + bj * HALF;
                const f32x4 g0 = *(const f32x4*)(cs + c), g1 = *(const f32x4*)(cs + c + 4);
#pragma unroll
                for (int ai = 0; ai < 2; ++ai)
#pragma unroll
                    for (int m = 0; m < 4; ++m) {
                        const int r = row0 + ai * HALF + m * 16, rl = r & (BM - 1);
                        const float rs = rsv[rl];
                        const u32x4 xb = *(const u32x4*)(X2 + (size_t)r * ldx + c);
                        const f32x4 v0 = acc[ai][bj][m][0], v1 = acc[ai][bj][m][1];
                        f32x4 o0, o1;
                        o0[0] = bf_lo(xb[0]) + v0[0] * rs * g0[0]; o0[1] = bf_hi(xb[0]) + v0[1] * rs * g0[1]; o0[2] = bf_lo(xb[1]) + v0[2] * rs * g0[2]; o0[3] = bf_hi(xb[1]) + v0[3] * rs * g0[3];
                        o1[0] = bf_lo(xb[2]) + v1[0] * rs * g1[0]; o1[1] = bf_hi(xb[2]) + v1[1] * rs * g1[1]; o1[2] = bf_lo(xb[3]) + v1[2] * rs * g1[2]; o1[3] = bf_hi(xb[3]) + v1[3] * rs * g1[3];
                        float* op = Of + (size_t)r * DM + c;
                        *(f32x4*)op = o0; *(f32x4*)(op + 4) = o1;
                    }
            }
            if (wr == 1) __builtin_amdgcn_s_barrier();
        } else
        if constexpr (MODE == EPI_DOWNF) {
            if (wr == 0) __builtin_amdgcn_s_barrier();
            row_rs_exchange(acc, u, wr, wc, fr, fq, ldsp, xch, cnt);
            LAS float* rsv = (LAS float*)(ldsp + CW_OFF + 4096);
#pragma unroll
            for (int bj = 0; bj < 2; ++bj) {
                const int c = colb + bj * HALF;
                const f32x4 g0 = *(const f32x4*)(cs + c), g1 = *(const f32x4*)(cs + c + 4);
#pragma unroll
                for (int ai = 0; ai < 2; ++ai)
#pragma unroll
                    for (int m = 0; m < 4; ++m) {
                        const int r = row0 + ai * HALF + m * 16, rl = r & (BM - 1);
                        const float rs = rsv[rl];
                        const u32x4 xb = *(const u32x4*)(X2 + (size_t)r * ldx + c);
                        const f32x4 v0 = acc[ai][bj][m][0], v1 = acc[ai][bj][m][1];
                        u32x4 o;
                        o[0] = cvt_pk_bf16(bf_lo(xb[0]) + v0[0] * rs * g0[0], bf_hi(xb[0]) + v0[1] * rs * g0[1]); o[1] = cvt_pk_bf16(bf_lo(xb[1]) + v0[2] * rs * g0[2], bf_hi(xb[1]) + v0[3] * rs * g0[3]);
                        o[2] = cvt_pk_bf16(bf_lo(xb[2]) + v1[0] * rs * g1[0], bf_hi(xb[2]) + v1[1] * rs * g1[1]); o[3] = cvt_pk_bf16(bf_lo(xb[3]) + v1[2] * rs * g1[2], bf_hi(xb[3]) + v1[3] * rs * g1[3]);
                        *(u32x4*)(O + (size_t)r * ldc + c) = o;
                    }
            }
            if (wr == 1) __builtin_amdgcn_s_barrier();
        } else if constexpr (MODE == EPI_OUTF) {
            if (wr == 0) __builtin_amdgcn_s_barrier();
            const __attribute__((address_space(4))) Params* kq = (const __attribute__((address_space(4))) Params*)__builtin_amdgcn_kernarg_segment_ptr();
            asm volatile("" : "+s"(kq));
            bf16_t* const O = (bf16_t*)kq->out; unsigned char* const wsp = kq->ws; const float* const cs = kq->in[9]; const float* const cb = kq->in[10];
            bf16_t* const Ob = (bf16_t*)(wsp + WS_H);
            float* const xch = (float*)(wsp + WS_XCH) + 1 * 64 * 8 * 256; unsigned* const cnt = (unsigned*)(wsp + WS_BAR) + XCNT_WORD0 + 1 * 64 * 64;
            row_rs_exchange(acc, u, wr, wc, fr, fq, ldsp, xch, cnt);
            LAS float* rsv = (LAS float*)(ldsp + CW_OFF + 4096);
#pragma unroll
            for (int bj = 0; bj < 2; ++bj) {
                __builtin_amdgcn_sched_barrier(0);
                const int c = colb + bj * HALF;
                const f32x4 g0 = *(const f32x4*)(cs + c), g1 = *(const f32x4*)(cs + c + 4);
#pragma unroll
                for (int ai = 0; ai < 2; ++ai)
#pragma unroll
                    for (int m = 0; m < 4; ++m) {
                        const int r = row0 + ai * HALF + m * 16, rl = r & (BM - 1);
                        const float rs = rsv[rl];
                        const unsigned off = (unsigned)(r * DM + c) * 2u;
                        const u32x4 xb = *(const u32x4*)((const char*)O + (size_t)MTOK * DM * 2 + off);
                        f32x4& v0 = acc[ai][bj][m][0]; f32x4& v1 = acc[ai][bj][m][1];
                        v0[0] = bf_lo(xb[0]) + v0[0] * rs * g0[0]; v0[1] = bf_hi(xb[0]) + v0[1] * rs * g0[1]; v0[2] = bf_lo(xb[1]) + v0[2] * rs * g0[2]; v0[3] = bf_hi(xb[1]) + v0[3] * rs * g0[3];
                        v1[0] = bf_lo(xb[2]) + v1[0] * rs * g1[0]; v1[1] = bf_hi(xb[2]) + v1[1] * rs * g1[1]; v1[2] = bf_lo(xb[3]) + v1[2] * rs * g1[2]; v1[3] = bf_hi(xb[3]) + v1[3] * rs * g1[3];
                    }
                asm volatile("" ::: "memory");
            }
#pragma unroll
            for (int bj = 0; bj < 2; ++bj)
#pragma unroll
                for (int ai = 0; ai < 2; ++ai)
#pragma unroll
                    for (int m = 0; m < 4; ++m) {
                        const int r = row0 + ai * HALF + m * 16;
                        const unsigned off = (unsigned)(r * DM + colb + bj * HALF) * 2u;
                        const f32x4 v0 = acc[ai][bj][m][0], v1 = acc[ai][bj][m][1];
                        u32x4 o; o[0] = cvt_pk_bf16(v0[0], v0[1]); o[1] = cvt_pk_bf16(v0[2], v0[3]); o[2] = cvt_pk_bf16(v1[0], v1[1]); o[3] = cvt_pk_bf16(v1[2], v1[3]);
                        *(u32x4*)((char*)O + off) = o;
                    }
            row_rs_exchange(acc, u, wr, wc, fr, fq, ldsp, xch + 64 * 8 * 256, cnt + 64 * 64);
#pragma unroll
            for (int bj = 0; bj < 2; ++bj) {
                const int c = colb + bj * HALF;
                const f32x4 g0 = *(const f32x4*)(cb + c), g1 = *(const f32x4*)(cb + c + 4);
#pragma unroll
                for (int ai = 0; ai < 2; ++ai)
#pragma unroll
                    for (int m = 0; m < 4; ++m) {
                        const int r = row0 + ai * HALF + m * 16, rl = r & (BM - 1);
                        const float rs = rsv[rl];
                        const unsigned off = (unsigned)(r * DM + c) * 2u;
                        const f32x4 h0 = acc[ai][bj][m][0] * g0 * rs, h1 = acc[ai][bj][m][1] * g1 * rs;
                        u32x4 oh; oh[0] = cvt_pk_bf16(h0[0], h0[1]); oh[1] = cvt_pk_bf16(h0[2], h0[3]); oh[2] = cvt_pk_bf16(h1[0], h1[1]); oh[3] = cvt_pk_bf16(h1[2], h1[3]);
                        *(u32x4*)((char*)Ob + off) = oh;
                    }
            }
            if (wr == 1) __builtin_amdgcn_s_barrier();
        } else
        if constexpr (MODE == EPI_UP) {
            const int ch0 = u.pn * 128 + wc * 32 + 8 * fq;
            const int blk0 = u.pm * 4 + wr;
            const int rowp = u.pm * BM + wr * 64 + 4 * fr;
            const LAS unsigned char* wp = ldsp + CW_OFF + (wr * 4 + wc) * 1024 + fq * 32;
            if (fr == 0 || fr == 15) {
                const bool lo = fr == 0;
                float* hp0 = halo + (size_t)(blk0 * 4 + (lo ? 0 : 2)) * UPW + ch0;
#pragma unroll
                for (int ai = 0; ai < 2; ++ai)
#pragma unroll
                    for (int bj = 0; bj < 2; ++bj)
#pragma unroll
                        for (int n = 0; n < 2; ++n) {
                            const f32x4 a0 = acc[ai][bj][0][n], a1 = acc[ai][bj][1][n], a2 = acc[ai][bj][2][n], a3 = acc[ai][bj][3][n];
                            f32x4 va, vb;
#pragma unroll
                            for (int e = 0; e < 4; ++e) { va[e] = lo ? a0[e] : a2[e]; vb[e] = lo ? a1[e] : a3[e]; }
                            float* hp = hp0 + (size_t)(ai * 8) * UPW + bj * DFF + 4 * n;
                            *(f32x4*)hp = va; *(f32x4*)(hp + UPW) = vb;
                        }
            }
#pragma unroll
            for (int n = 0; n < 2; ++n) {
                const int ch = ch0 + 4 * n;
#pragma unroll
                for (int ai = 0; ai < 2; ++ai) {
                    f32x4 Gc[4];
#pragma unroll
                    for (int bj = 0; bj < 2; ++bj) {
                        const int cc = bj * DFF + ch;
                        const LAS unsigned char* wq = wp + bj * 128 + n * 16;
                        const f32x4 w0 = *(const LAS f32x4*)(wq), w1 = *(const LAS f32x4*)(wq + 256), w2 = *(const LAS f32x4*)(wq + 512), bb = *(const LAS f32x4*)(wq + 768);
                        const f32x4 X0 = acc[ai][bj][0][n], X1v = acc[ai][bj][1][n], X2v = acc[ai][bj][2][n], X3 = acc[ai][bj][3][n];
                        const f32x4 S3 = shr1v(X3), S2 = shr1v(X2v);
                        f32x4 cv[4];
                        cv[0] = bb + w2 * X0 + w1 * S3 + w0 * S2;
                        cv[1] = bb + w2 * X1v + w1 * X0 + w0 * S3;
                        cv[2] = bb + w2 * X2v + w1 * X1v + w0 * X0;
                        cv[3] = bb + w2 * X3 + w1 * X2v + w0 * X1v;
#pragma unroll
                        for (int m = 0; m < 4; ++m) {
                            if (bj == 0) Gc[m] = cv[m];
                            else {
                                const f32x4 g = Gc[m];
                                u32x2 o; o[0] = cvt_pk_bf16(gelu_mul(g[0], cv[m][0]), gelu_mul(g[1], cv[m][1])); o[1] = cvt_pk_bf16(gelu_mul(g[2], cv[m][2]), gelu_mul(g[3], cv[m][3]));
                                *(u32x2*)(O + (size_t)(rowp + ai * HALF + m) * DFF + ch) = o;
                            }
                        }
                    }
                }
            }
        } else {
            bf16_t* base = O; int ld = ldc, coff = 0; float sc = 1.0f;
            if constexpr (MODE == EPI_PROJ) {
                const int pn = u.pn;
                if (pn < 4) { base = (bf16_t*)(ws + WS_Q); ld = 1024; coff = 0; sc = qscale; }
                else if (pn < 8) { base = (bf16_t*)(ws + WS_K); ld = 1024; coff = 1024; }
                else if (pn < 12) { base = (bf16_t*)(ws + WS_U); ld = 1024; coff = 2048; }
                else if (pn < 20) { base = (bf16_t*)(ws + WS_GA); ld = 2048; coff = 3072; }
                else { base = (bf16_t*)(ws + WS_GP); ld = 2048; coff = 5120; }
            }
#pragma unroll
            for (int bj = 0; bj < 2; ++bj) {
                const int c = colb + bj * HALF;
                f32x4 cs0 = (f32x4){sc, sc, sc, sc}, cs1 = cs0;
                if constexpr (MODE == EPI_PLAIN) { if (cs) { cs0 = *(const f32x4*)(cs + c); cs1 = *(const f32x4*)(cs + c + 4); } }
#pragma unroll
                for (int ai = 0; ai < 2; ++ai)
#pragma unroll
                    for (int m = 0; m < 4; ++m) {
                        const int r = row0 + ai * HALF + m * 16;
                        f32x4 v0 = acc[ai][bj][m][0] * cs0, v1 = acc[ai][bj][m][1] * cs1;
                        if constexpr (MODE == EPI_GATE1 || MODE == EPI_GATE2) {
                            const u32x4 g = *(const u32x4*)(X1 + (size_t)r * ldx + c);
                            v0[0] *= sigmoidf_(bf_lo(g[0])); v0[1] *= sigmoidf_(bf_hi(g[0])); v0[2] *= sigmoidf_(bf_lo(g[1])); v0[3] *= sigmoidf_(bf_hi(g[1]));
                            v1[0] *= sigmoidf_(bf_lo(g[2])); v1[1] *= sigmoidf_(bf_hi(g[2])); v1[2] *= sigmoidf_(bf_lo(g[3])); v1[3] *= sigmoidf_(bf_hi(g[3]));
                            if constexpr (MODE == EPI_GATE2) {
                                const u32x4 t = *(const u32x4*)(X2 + (size_t)r * ldx + c);
                                v0[0] += bf_lo(t[0]); v0[1] += bf_hi(t[0]); v0[2] += bf_lo(t[1]); v0[3] += bf_hi(t[1]);
                                v1[0] += bf_lo(t[2]); v1[1] += bf_hi(t[2]); v1[2] += bf_lo(t[3]); v1[3] += bf_hi(t[3]);
                            }
                        }
                        if constexpr (MODE == EPI_PLE) {
                            const u32x4 e = *(const u32x4*)(X1 + (size_t)r * ldx + c);
                            v0[0] = sigmoidf_(v0[0]) * bf_lo(e[0]); v0[1] = sigmoidf_(v0[1]) * bf_hi(e[0]); v0[2] = sigmoidf_(v0[2]) * bf_lo(e[1]); v0[3] = sigmoidf_(v0[3]) * bf_hi(e[1]);
                            v1[0] = sigmoidf_(v1[0]) * bf_lo(e[2]); v1[1] = sigmoidf_(v1[1]) * bf_hi(e[2]); v1[2] = sigmoidf_(v1[2]) * bf_lo(e[3]); v1[3] = sigmoidf_(v1[3]) * bf_hi(e[3]);
                        }
                        u32x4 o; o[0] = cvt_pk_bf16(v0[0], v0[1]); o[1] = cvt_pk_bf16(v0[2], v0[3]); o[2] = cvt_pk_bf16(v1[0], v1[1]); o[3] = cvt_pk_bf16(v1[2], v1[3]);
                        *(u32x4*)(base + (size_t)r * ld + (c - coff)) = o;
                    }
            }
        }
    }
};

template <class EpiT, class Sched>
__device__ __forceinline__ void gemm_phase(LAS unsigned char* lds, const Gemm g, const Sched& S, const EpiT& E) {
    const int tid = tidx(), wid = __builtin_amdgcn_readfirstlane(tid >> 6), lane = tid & 63, wr = wid >> 2, wc = wid & 3, fr = lane & 15, fq = lane >> 4;
    const int K = g.K, nt = K / BK;
    unsigned voffA[2], voffB[2];
#pragma unroll
    for (int i = 0; i < 2; ++i) { int R, C; stage_rc(tid * 16 + i * 8192, R, C); const int Rb = (R & ~31) + perm32(R & 31);
        const int Ra = EpiT::PERMA ? ((R & ~63) + 4 * (R & 15) + ((R >> 4) & 3)) : R;
        voffA[i] = (unsigned)(Ra * g.lda + C) * 2u; voffB[i] = (unsigned)(Rb * g.ldb + C) * 2u; }
    const size_t kstep = (size_t)(BK * 2);
    const size_t hstepA = (size_t)HALF * g.lda * 2, hstepB = (size_t)HALF * g.ldb * 2;
    const size_t tstepA = 2 * hstepA, tstepB = 2 * hstepB;
    const unsigned ldsw = (unsigned)wid * 1024u;
    const int aoff = lds_byte(wr * 64 + fr, fq * 8), boff = lds_byte(wc * 32 + fr, fq * 8);
#define PG8_SA(b, h) (((b) * 2 + (h)) * HTB)
#define PG8_SB(b, h) ((4 + (b) * 2 + (h)) * HTB)
#define PG8_STAGE(bufoff, gbase, voff) do { _Pragma("unroll") for (int _i = 0; _i < 2; ++_i) \
        __builtin_amdgcn_global_load_lds((const unsigned*)((const char*)(gbase) + (voff)[_i]), (LAS unsigned*)(lds + (bufoff) + ldsw + _i * 8192), 16, 0, 0); } while (0)
#define PG8_LDA(dst, b, h) do { _Pragma("unroll") for (int m = 0; m < 4; ++m) _Pragma("unroll") for (int k = 0; k < 2; ++k) dst[m][k] = *(const LAS bf16x8*)(lds + PG8_SA(b, h) + aoff + m * 2048 + k * 1024); } while (0)
#define PG8_LDB(dst, b, h) do { _Pragma("unroll") for (int n = 0; n < 2; ++n) _Pragma("unroll") for (int k = 0; k < 2; ++k) dst[n][k] = *(const LAS bf16x8*)(lds + PG8_SB(b, h) + boff + n * 2048 + k * 1024); } while (0)
#define PG8_MMA(ai, bj, At, Bt) do { __builtin_amdgcn_s_setprio(1); _Pragma("unroll") for (int m = 0; m < 4; ++m) _Pragma("unroll") for (int n = 0; n < 2; ++n) _Pragma("unroll") for (int k = 0; k < 2; ++k) \
        acc[ai][bj][m][n] = __builtin_amdgcn_mfma_f32_16x16x32_bf16(Bt[n][k], At[m][k], acc[ai][bj][m][n], 0, 0, 0); __builtin_amdgcn_s_setprio(0); } while (0)
#define PG8_WAIT_V(n) asm volatile("s_waitcnt vmcnt(" #n ")" ::: "memory")
#define PG8_WAIT_L(n) asm volatile("s_waitcnt lgkmcnt(" #n ")" ::: "memory")
#define PG8_BAR __builtin_amdgcn_s_barrier()
#define PG8_SCHED __builtin_amdgcn_sched_barrier(0)
    Unit cur, nxt; int ui = 0;
    if (!S.next(0, cur)) return;
    f32x4 acc[2][2][4][2];
#pragma unroll
    for (int a = 0; a < 2; ++a)
#pragma unroll
        for (int b = 0; b < 2; ++b)
#pragma unroll
            for (int m = 0; m < 4; ++m)
#pragma unroll
                for (int n = 0; n < 2; ++n) acc[a][b][m][n] = (f32x4){0.f, 0.f, 0.f, 0.f};
    bf16x8 At[4][2], B0[2][2], B1[2][2];
    const char* cA = (const char*)g.A + (size_t)cur.pm * tstepA; const char* cB = (const char*)g.Bt + (size_t)cur.pn * tstepB;
    PG8_STAGE(PG8_SB(0, 0), cB, voffB); PG8_STAGE(PG8_SA(0, 0), cA, voffA); PG8_STAGE(PG8_SB(0, 1), cB + hstepB, voffB); PG8_STAGE(PG8_SA(0, 1), cA + hstepA, voffA);
    if (wr == 1) PG8_BAR;
    PG8_WAIT_V(4); PG8_BAR;
    PG8_STAGE(PG8_SB(1, 0), cB + kstep, voffB); PG8_STAGE(PG8_SA(1, 0), cA + kstep, voffA); PG8_STAGE(PG8_SB(1, 1), cB + hstepB + kstep, voffB);
    PG8_WAIT_V(6); PG8_BAR;
    for (;;) {
        const bool has_next = S.next(ui + 1, nxt);
        const char* nA = has_next ? (const char*)g.A + (size_t)nxt.pm * tstepA : cA; const char* nB = has_next ? (const char*)g.Bt + (size_t)nxt.pn * tstepB : cB;
        for (int t = 0; t < nt; t += 2) {
            const bool last = (t == nt - 2);
            if constexpr (EpiT::PREFETCH) { if (last) E.prefetch(cur, wid, lane); }
            const char* a1 = cA + (size_t)(t + 1) * kstep;
            const char* a2 = last ? nA : cA + (size_t)(t + 2) * kstep; const char* b2 = last ? nB : cB + (size_t)(t + 2) * kstep;
            const char* a3 = a2 + kstep; const char* b3 = b2 + kstep;
            PG8_LDB(B0, 0, 0); PG8_SCHED; PG8_LDA(At, 0, 0); PG8_STAGE(PG8_SA(1, 1), a1 + hstepA, voffA);
            PG8_WAIT_L(8); PG8_BAR; PG8_WAIT_L(0); PG8_MMA(0, 0, At, B0); PG8_BAR; PG8_SCHED;
            PG8_LDB(B1, 0, 1); PG8_STAGE(PG8_SB(0, 0), b2, voffB);
            PG8_BAR; PG8_WAIT_L(0); PG8_MMA(0, 1, At, B1); PG8_BAR;
            PG8_LDA(At, 0, 1); PG8_STAGE(PG8_SA(0, 0), a2, voffA);
            PG8_BAR; PG8_WAIT_L(0); PG8_MMA(1, 0, At, B0); PG8_BAR; PG8_SCHED;
            PG8_STAGE(PG8_SB(0, 1), b2 + hstepB, voffB);
            PG8_WAIT_V(6); PG8_BAR; PG8_MMA(1, 1, At, B1); PG8_BAR;
            PG8_LDB(B0, 1, 0); PG8_SCHED; PG8_LDA(At, 1, 0); PG8_STAGE(PG8_SA(0, 1), a2 + hstepA, voffA);
            PG8_WAIT_L(8); PG8_BAR; PG8_WAIT_L(0); PG8_MMA(0, 0, At, B0); PG8_BAR; PG8_SCHED;
            PG8_LDB(B1, 1, 1); PG8_STAGE(PG8_SB(1, 0), b3, voffB);
            PG8_BAR; PG8_WAIT_L(0); PG8_MMA(0, 1, At, B1); PG8_BAR;
            PG8_LDA(At, 1, 1); PG8_STAGE(PG8_SA(1, 0), a3, voffA);
            PG8_BAR; PG8_WAIT_L(0); PG8_MMA(1, 0, At, B0); PG8_BAR; PG8_SCHED;
            PG8_STAGE(PG8_SB(1, 1), b3 + hstepB, voffB);
            PG8_WAIT_V(6); PG8_BAR; PG8_MMA(1, 1, At, B1); PG8_BAR;
        }
        E(acc, cur, wr, wc, fr, fq);
        if (!has_next) break;
#pragma unroll
        for (int a = 0; a < 2; ++a)
#pragma unroll
            for (int b = 0; b < 2; ++b)
#pragma unroll
                for (int m = 0; m < 4; ++m)
#pragma unroll
                    for (int n = 0; n < 2; ++n) acc[a][b][m][n] = (f32x4){0.f, 0.f, 0.f, 0.f};
        cur = nxt; cA = nA; cB = nB; ++ui;
    }
    PG8_WAIT_V(0);
    if (wr == 0) PG8_BAR;
    PG8_BAR;
#undef PG8_SA
#undef PG8_SB
#undef PG8_STAGE
#undef PG8_LDA
#undef PG8_LDB
#undef PG8_MMA
#undef PG8_WAIT_V
#undef PG8_WAIT_L
#undef PG8_BAR
#undef PG8_SCHED
}

template <int MODE>
__device__ __forceinline__ void run_gemm_panel(LAS unsigned char* lds, const bf16_t* A, int lda, const bf16_t* Bt, int ldb, int M, int N, int K, const Epi<MODE>& E) {
    Gemm g; g.A = A; g.Bt = Bt; g.M = M; g.N = N; g.K = K; g.lda = lda; g.ldb = ldb;
    PanelOrder S; S.init(M, N, (int)gridDim.x, (int)blockIdx.x);
    gemm_phase(lds, g, S, E);
}
template <int MODE>
__device__ __forceinline__ void run_gemm(LAS unsigned char* lds, const bf16_t* A, int lda, const bf16_t* Bt, int ldb, int M, int N, int K, const Epi<MODE>& E, int crot = 0) {
    Gemm g; g.A = A; g.Bt = Bt; g.M = M; g.N = N; g.K = K; g.lda = lda; g.ldb = ldb;
    int cc = (int)blockIdx.x - crot; if (cc < 0) cc += (int)gridDim.x;
    StaticOrder S; S.init(M, N, (int)gridDim.x, cc);
    gemm_phase(lds, g, S, E);
}

__device__ __forceinline__ void cvt_transpose(const float* __restrict__ W, bf16_t* __restrict__ Wt, int K, int N, int ldt, int mode, float* tile) {
    const int tid = tidx(), ntn = N / 64, ntk = K / 64, ntile = ntn * ntk, G = (int)gridDim.x;
    const int kk0 = tid >> 4, n4 = (tid & 15) * 4;
    float4 nx0 = make_float4(0.f, 0.f, 0.f, 0.f), nx1 = nx0;
    int t = (int)blockIdx.x;
    if (t < ntile) { const int tk = t / ntn, tn = t % ntn; const float* p = W + (size_t)(tk * 64 + kk0) * N + tn * 64 + n4; nx0 = *(const float4*)p; nx1 = *(const float4*)(p + (size_t)32 * N); }
    for (; t < ntile; t += G) {
        const int tk = t / ntn, tn = t % ntn;
        const float4 v0 = nx0, v1 = nx1;
        const int t2 = t + G;
        if (t2 < ntile) { const int tk2 = t2 / ntn, tn2 = t2 % ntn; const float* p = W + (size_t)(tk2 * 64 + kk0) * N + tn2 * 64 + n4; nx0 = *(const float4*)p; nx1 = *(const float4*)(p + (size_t)32 * N); }
        tile[(n4 + 0) * 65 + kk0] = v0.x; tile[(n4 + 1) * 65 + kk0] = v0.y; tile[(n4 + 2) * 65 + kk0] = v0.z; tile[(n4 + 3) * 65 + kk0] = v0.w;
        tile[(n4 + 0) * 65 + kk0 + 32] = v1.x; tile[(n4 + 1) * 65 + kk0 + 32] = v1.y; tile[(n4 + 2) * 65 + kk0 + 32] = v1.z; tile[(n4 + 3) * 65 + kk0 + 32] = v1.w;
        __syncthreads();
        {
            const int n = tid >> 3, k8 = (tid & 7) * 8;
            int n0 = tn * 64;
            if (mode == 1) { n0 = n0 < 2048 ? n0 : (n0 < 3072 ? n0 + 5120 : n0 - 1024); }
            else if (mode == 2) { const int bj = n0 >= DFF ? 1 : 0, ch = n0 - bj * DFF; n0 = 256 * (ch >> 7) + 128 * bj + (ch & 127); }
            const float* tp = tile + n * 65 + k8;
            u32x4 o; o[0] = cvt_pk_bf16(tp[0], tp[1]); o[1] = cvt_pk_bf16(tp[2], tp[3]); o[2] = cvt_pk_bf16(tp[4], tp[5]); o[3] = cvt_pk_bf16(tp[6], tp[7]);
            *(u32x4*)(Wt + (size_t)(n0 + n) * ldt + tk * 64 + k8) = o;
        }
        __syncthreads();
    }
}

template <bool XIN_BF16, int XO, bool HN>
__device__ __forceinline__ void row_pass(const bf16_t* __restrict__ y, const void* __restrict__ xin, const float* __restrict__ g1, void* __restrict__ xo, const float* __restrict__ g2, bf16_t* __restrict__ hb) {
    const int lane = tidx() & 63, gw = blockIdx.x * 8 + (tidx() >> 6), nw = gridDim.x * 8;
    for (int row = gw; row < MTOK; row += nw) {
        float4 v[8];
        if constexpr (XIN_BF16) {
            const u32x2* xr = (const u32x2*)((const bf16_t*)xin + (size_t)row * DM);
#pragma unroll
            for (int i = 0; i < 8; ++i) { const u32x2 w = xr[lane + 64 * i]; v[i] = make_float4(bf_lo(w[0]), bf_hi(w[0]), bf_lo(w[1]), bf_hi(w[1])); }
        } else {
            const float4* xr = (const float4*)((const float*)xin + (size_t)row * DM);
#pragma unroll
            for (int i = 0; i < 8; ++i) v[i] = xr[lane + 64 * i];
        }
        if (y) {
            const u32x2* yr = (const u32x2*)(y + (size_t)row * DM);
            float4 yv[8]; float ss = 0.f;
#pragma unroll
            for (int i = 0; i < 8; ++i) { const u32x2 w = yr[lane + 64 * i]; yv[i] = make_float4(bf_lo(w[0]), bf_hi(w[0]), bf_lo(w[1]), bf_hi(w[1])); ss += yv[i].x * yv[i].x + yv[i].y * yv[i].y + yv[i].z * yv[i].z + yv[i].w * yv[i].w; }
            ss = wave_sum(ss);
            const float rs = rsqrtf(ss * (1.0f / DM) + EPS);
#pragma unroll
            for (int i = 0; i < 8; ++i) { const float4 gg = ((const float4*)g1)[lane + 64 * i];
                v[i].x += yv[i].x * rs * gg.x; v[i].y += yv[i].y * rs * gg.y; v[i].z += yv[i].z * rs * gg.z; v[i].w += yv[i].w * rs * gg.w; }
        }
        if constexpr (XO == 1) {
#pragma unroll
            for (int i = 0; i < 8; ++i) ((float4*)((float*)xo + (size_t)row * DM))[lane + 64 * i] = v[i];
        } else if constexpr (XO == 2) {
#pragma unroll
            for (int i = 0; i < 8; ++i) { u32x2 o; o[0] = cvt_pk_bf16(v[i].x, v[i].y); o[1] = cvt_pk_bf16(v[i].z, v[i].w); ((u32x2*)((bf16_t*)xo + (size_t)row * DM))[lane + 64 * i] = o; }
        }
        if constexpr (HN) {
            float ss = 0.f;
#pragma unroll
            for (int i = 0; i < 8; ++i) ss += v[i].x * v[i].x + v[i].y * v[i].y + v[i].z * v[i].z + v[i].w * v[i].w;
            ss = wave_sum(ss);
            const float rs = rsqrtf(ss * (1.0f / DM) + EPS);
#pragma unroll
            for (int i = 0; i < 8; ++i) { const float4 gg = ((const float4*)g2)[lane + 64 * i];
                u32x2 o; o[0] = cvt_pk_bf16(v[i].x * rs * gg.x, v[i].y * rs * gg.y); o[1] = cvt_pk_bf16(v[i].z * rs * gg.z, v[i].w * rs * gg.w);
                ((u32x2*)(hb + (size_t)row * DM))[lane + 64 * i] = o; }
        }
    }
}

__device__ __forceinline__ void x_pass(const float* __restrict__ x, bf16_t* __restrict__ xb, const float* __restrict__ g, bf16_t* __restrict__ hb) {
    const int lane = tidx() & 63, gw = blockIdx.x * 8 + (tidx() >> 6), nw = gridDim.x * 8;
    float4 nx[8];
    int row = gw;
    if (row < MTOK) {
        const float4* xr = (const float4*)(x + (size_t)row * DM);
#pragma unroll
        for (int i = 0; i < 8; ++i) nx[i] = xr[lane + 64 * i];
    }
    for (; row < MTOK; row += nw) {
        float4 v[8];
#pragma unroll
        for (int i = 0; i < 8; ++i) v[i] = nx[i];
        if (row + nw < MTOK) {
            const float4* xr = (const float4*)(x + (size_t)(row + nw) * DM);
#pragma unroll
            for (int i = 0; i < 8; ++i) nx[i] = xr[lane + 64 * i];
        }
        float ss = 0.f;
#pragma unroll
        for (int i = 0; i < 8; ++i) ss += v[i].x * v[i].x + v[i].y * v[i].y + v[i].z * v[i].z + v[i].w * v[i].w;
        ss = wave_sum(ss);
        const float rs = rsqrtf(ss * (1.0f / DM) + EPS);
#pragma unroll
        for (int i = 0; i < 8; ++i) {
            const float4 gg = ((const float4*)g)[lane + 64 * i];
            u32x2 o; o[0] = cvt_pk_bf16(v[i].x, v[i].y); o[1] = cvt_pk_bf16(v[i].z, v[i].w);
            ((u32x2*)(xb + (size_t)row * DM))[lane + 64 * i] = o;
            u32x2 oh; oh[0] = cvt_pk_bf16(v[i].x * rs * gg.x, v[i].y * rs * gg.y); oh[1] = cvt_pk_bf16(v[i].z * rs * gg.z, v[i].w * rs * gg.w);
            ((u32x2*)(hb + (size_t)row * DM))[lane + 64 * i] = oh;
        }
    }
}

template <int W>
__device__ __forceinline__ void pool_group(const bf16_t* __restrict__ U, bf16_t* __restrict__ P1, int grp) {
    const int nthr = gridDim.x * 512, nit = MTOK * 32;
    u32x4 nx[W];
    int it = blockIdx.x * 512 + tidx();
#define POOL_LOAD(itx) do { const int _tok = (itx) >> 5, _c8 = grp * 256 + ((itx) & 31) * 8, _tl = _tok & (SEQ - 1); const int _cnt = (_tl + 1) < W ? (_tl + 1) : W; \
        _Pragma("unroll") for (int j = 0; j < W; ++j) nx[j] = *(const u32x4*)(U + (size_t)(_tok - (j < _cnt ? j : 0)) * PW + _c8); } while (0)
    if (it < nit) POOL_LOAD(it);
    for (; it < nit; it += nthr) {
        const int tok = it >> 5, c8 = grp * 256 + (it & 31) * 8, tl = tok & (SEQ - 1);
        const int cnt = (tl + 1) < W ? (tl + 1) : W;
        u32x4 v[W];
#pragma unroll
        for (int j = 0; j < W; ++j) v[j] = nx[j];
        if (it + nthr < nit) POOL_LOAD(it + nthr);
        float s[8] = {0.f, 0.f, 0.f, 0.f, 0.f, 0.f, 0.f, 0.f}, u0[8];
#pragma unroll
        for (int j = 0; j < W; ++j) {
            const bool in = j < cnt;
            const float f[8] = {bf_lo(v[j][0]), bf_hi(v[j][0]), bf_lo(v[j][1]), bf_hi(v[j][1]), bf_lo(v[j][2]), bf_hi(v[j][2]), bf_lo(v[j][3]), bf_hi(v[j][3])};
#pragma unroll
            for (int e = 0; e < 8; ++e) { s[e] += in ? f[e] : 0.f; if (j == 0) u0[e] = f[e]; }
        }
        const float inv = 1.0f / (float)cnt;
        u32x4 o;
        o[0] = cvt_pk_bf16(s[0] * inv - u0[0], s[1] * inv - u0[1]); o[1] = cvt_pk_bf16(s[2] * inv - u0[2], s[3] * inv - u0[3]);
        o[2] = cvt_pk_bf16(s[4] * inv - u0[4], s[5] * inv - u0[5]); o[3] = cvt_pk_bf16(s[6] * inv - u0[6], s[7] * inv - u0[7]);
        *(u32x4*)(P1 + (size_t)tok * PW + c8) = o;
    }
#undef POOL_LOAD
}
__device__ __forceinline__ void pool_pass(const bf16_t* __restrict__ U, bf16_t* __restrict__ P1) {
    pool_group<2>(U, P1, 0); pool_group<4>(U, P1, 1); pool_group<8>(U, P1, 2); pool_group<16>(U, P1, 3);
}

__device__ __forceinline__ void conv_fixup(const float* __restrict__ halo, const float* __restrict__ cw, const float* __restrict__ cb, bf16_t* __restrict__ act) {
    const int nthr = gridDim.x * 512, nq = DFF / 4;
    for (int it = blockIdx.x * 512 + tidx(); it < 512 * nq; it += nthr) {
        const int ri = it / nq, ch = (it % nq) * 4, blk = ri >> 1, i = ri & 1;
        const bool first = (blk & 63) == 0;
        f32x4 res[2];
#pragma unroll
        for (int bj = 0; bj < 2; ++bj) {
            const int cc = bj * DFF + ch;
            const f32x4 z = (f32x4){0.f, 0.f, 0.f, 0.f};
            const f32x4 cur = *(const f32x4*)(halo + (size_t)(blk * 4 + i) * UPW + cc);
            f32x4 p1, p2;
            if (i == 0) { p1 = first ? z : *(const f32x4*)(halo + (size_t)((blk - 1) * 4 + 3) * UPW + cc); p2 = first ? z : *(const f32x4*)(halo + (size_t)((blk - 1) * 4 + 2) * UPW + cc); }
            else { p1 = *(const f32x4*)(halo + (size_t)(blk * 4 + 0) * UPW + cc); p2 = first ? z : *(const f32x4*)(halo + (size_t)((blk - 1) * 4 + 3) * UPW + cc); }
            res[bj] = *(const f32x4*)(cb + cc) + *(const f32x4*)(cw + 2 * UPW + cc) * cur + *(const f32x4*)(cw + UPW + cc) * p1 + *(const f32x4*)(cw + cc) * p2;
        }
        u32x2 o; o[0] = cvt_pk_bf16(gelu_mul(res[0][0], res[1][0]), gelu_mul(res[0][1], res[1][1])); o[1] = cvt_pk_bf16(gelu_mul(res[0][2], res[1][2]), gelu_mul(res[0][3], res[1][3]));
        *(u32x2*)(act + (size_t)(blk * 64 + i) * DFF + ch) = o;
    }
}

__device__ __forceinline__ void k_load(bf16x8 (&k)[8], const bf16_t* kbase, int kt) {
    const bf16_t* kp = kbase + (size_t)kt * 32 * AW;
#pragma unroll
    for (int kk = 0; kk < 8; ++kk) k[kk] = *(const bf16x8*)(kp + 16 * kk);
}
__device__ __forceinline__ void v_load(bf16x8 (&v)[8], const bf16_t* vbase, int kt) {
    const bf16_t* vp = vbase + kt * 32;
#pragma unroll
    for (int d = 0; d < 4; ++d)
#pragma unroll
        for (int s = 0; s < 2; ++s) v[d * 2 + s] = *(const bf16x8*)(vp + (size_t)d * 32 * MTOK + 16 * s);
}
__device__ __forceinline__ void attn_item(const bf16_t* __restrict__ Q, const bf16_t* __restrict__ Kp, const bf16_t* __restrict__ Vt, bf16_t* __restrict__ AO, int b, int hd, int qblk, int lane) {
    const int r = lane & 31, h = lane >> 5;
    const int pr = (r & ~12) | ((r & 4) << 1) | ((r & 8) >> 1);
    const size_t tok0 = (size_t)b * SEQ + (size_t)qblk * 32;
    bf16x8 qf[8];
    const bf16_t* qp = Q + (tok0 + r) * AW + hd * 128 + 8 * h;
#pragma unroll
    for (int kk = 0; kk < 8; ++kk) qf[kk] = *(const bf16x8*)(qp + 16 * kk);
    f32x16 o[4];
#pragma unroll
    for (int d = 0; d < 4; ++d)
#pragma unroll
        for (int i = 0; i < 16; ++i) o[d][i] = 0.f;
    float carry = 0.f;
    const bf16_t* kbase = Kp + ((size_t)b * SEQ + pr) * AW + hd * 128 + 8 * h;
    const bf16_t* vbase = Vt + (size_t)(hd * 128 + r) * MTOK + (size_t)b * SEQ + 8 * h;
    bf16x8 kf[8], vf[8];
    k_load(kf, kbase, qblk);
    for (int kt = qblk; kt >= 0; --kt) {
        const bool diag = (kt == qblk);
        v_load(vf, vbase, kt);
        f32x16 s;
#pragma unroll
        for (int i = 0; i < 16; ++i) s[i] = 0.f;
#pragma unroll
        for (int kk = 0; kk < 8; ++kk) s = __builtin_amdgcn_mfma_f32_32x32x16_bf16(kf[kk], qf[kk], s, 0, 0, 0);
        if (kt > 0) k_load(kf, kbase, kt - 1);
        float T0 = 0.f, T1 = 0.f;
        float lm[16];
#pragma unroll
        for (int i = 0; i < 16; ++i) {
            const float y = s[i];
            const float e = __builtin_amdgcn_exp2f(-__builtin_fabsf(y));
            const float tt = __builtin_amdgcn_logf(1.0f + e);
            float lsv = fminf(y, 0.f) - tt;
            float lmv = lsv - y;
            if (diag) { const bool valid = (16 * (i >> 3) + 8 * h + (i & 7)) < r; lmv = valid ? lmv : 0.f; lsv = valid ? lsv : -1e30f; }
            s[i] = lsv; lm[i] = lmv;
            if (i < 8) T0 += lmv; else T1 += lmv;
        }
        const float OT0 = __shfl_xor(T0, 32), OT1 = __shfl_xor(T1, 32);
        const float after0 = (h == 0 ? OT0 : 0.f) + T1 + OT1, after1 = (h == 0 ? OT1 : 0.f);
        {
            float run = after0 + carry;
#pragma unroll
            for (int j = 7; j >= 0; --j) { s[j] = __builtin_amdgcn_exp2f(s[j] + run); run += lm[j]; }
            run = after1 + carry;
#pragma unroll
            for (int j = 7; j >= 0; --j) { s[8 + j] = __builtin_amdgcn_exp2f(s[8 + j] + run); run += lm[8 + j]; }
        }
        carry += (T0 + T1) + (OT0 + OT1);
        bf16x8 pf[2];
#pragma unroll
        for (int sI = 0; sI < 2; ++sI) {
            u32x4 w; w[0] = cvt_pk_bf16(s[8 * sI + 0], s[8 * sI + 1]); w[1] = cvt_pk_bf16(s[8 * sI + 2], s[8 * sI + 3]); w[2] = cvt_pk_bf16(s[8 * sI + 4], s[8 * sI + 5]); w[3] = cvt_pk_bf16(s[8 * sI + 6], s[8 * sI + 7]);
            pf[sI] = __builtin_bit_cast(bf16x8, w);
        }
#pragma unroll
        for (int d = 0; d < 4; ++d)
#pragma unroll
            for (int sI = 0; sI < 2; ++sI) o[d] = __builtin_amdgcn_mfma_f32_32x32x16_bf16(vf[d * 2 + sI], pf[sI], o[d], 0, 0, 0);
        if (__builtin_amdgcn_ballot_w64(carry > -150.0f) == 0ull) break;
    }
    bf16_t* op = AO + (tok0 + r) * AW + hd * 128 + 4 * h;
#pragma unroll
    for (int d = 0; d < 4; ++d)
#pragma unroll
        for (int j = 0; j < 4; ++j) { u32x2 w; w[0] = cvt_pk_bf16(o[d][4 * j + 0], o[d][4 * j + 1]); w[1] = cvt_pk_bf16(o[d][4 * j + 2], o[d][4 * j + 3]); *(u32x2*)(op + d * 32 + 8 * j) = w; }
}
__device__ __forceinline__ void attn_phase(const bf16_t* Q, const bf16_t* Kp, const bf16_t* Vt, bf16_t* AO) {
    const int lane = tidx() & 63, w = tidx() >> 6;
    for (int g = blockIdx.x; g < 256; g += gridDim.x) {
        const int xcd = g & 7, idx = g >> 3, bh = xcd * 4 + (idx >> 3), sub = idx & 7, x = sub * 8 + w;
        const int b = bh >> 3, hd = bh & 7;
        attn_item(Q, Kp, Vt, AO, b, hd, 127 - x, lane);
        attn_item(Q, Kp, Vt, AO, b, hd, x, lane);
    }
}

#ifndef FUSE_OUT
#define FUSE_OUT 1
#endif
#ifndef N_LAUNCH_MODE
#define N_LAUNCH_MODE 1
#endif
constexpr int NPHASE = 13;
template <int ph> __device__ __forceinline__ void run_phase(const Params& p, unsigned char* shm) {
    LAS unsigned char* lds = (LAS unsigned char*)shm;
    unsigned char* ws = p.ws;
    {
        if constexpr (ph == 0) {
            float* tile = (float*)shm;
            cvt_transpose(p.in[3], (bf16_t*)(ws + WS_WIN), DM, 8192, DM, 1, tile);
            cvt_transpose(p.in[4], (bf16_t*)(ws + WS_WAB), AW, DM, AW, 0, tile);
            cvt_transpose(p.in[5], (bf16_t*)(ws + WS_WPG), 1024, 256, 1024, 0, tile);
            cvt_transpose(p.in[7], (bf16_t*)(ws + WS_WPB), PW, DM, PW, 0, tile);
            cvt_transpose(p.in[8], (bf16_t*)(ws + WS_WOUT), DM, DM, DM, 0, tile);
            cvt_transpose(p.in[11], (bf16_t*)(ws + WS_WUP), DM, UPW, DM, 2, tile);
            cvt_transpose(p.in[14], (bf16_t*)(ws + WS_WDN), DFF, DM, DFF, 0, tile);
            cvt_transpose(p.in[16], (bf16_t*)(ws + WS_WPLE), PLE, DM, PLE, 0, tile);
            cvt_transpose(p.in[17], (bf16_t*)(ws + WS_WPGATE), DM, DM, DM, 0, tile);
            #if FUSE_OUT
            x_pass(p.in[0], (bf16_t*)p.out + (size_t)MTOK * DM, p.in[2], (bf16_t*)(ws + WS_H));
#else
            row_pass<false, 0, true>(nullptr, p.in[0], nullptr, nullptr, p.in[2], (bf16_t*)(ws + WS_H));
#endif
            {
                const float4* src = (const float4*)p.in[1]; u32x2* dst = (u32x2*)(ws + WS_PB);
                for (int i = blockIdx.x * 512 + tidx(); i < MTOK * PLE / 4; i += gridDim.x * 512) { const float4 v = src[i]; u32x2 o; o[0] = cvt_pk_bf16(v.x, v.y); o[1] = cvt_pk_bf16(v.z, v.w); dst[i] = o; }
            }
        } else if constexpr (ph == 1) {
            Epi<EPI_PROJ> e{}; e.ws = ws; e.qscale = 0.08838834764831845f * LOG2E;
            run_gemm(lds, (const bf16_t*)(ws + WS_H), DM, (const bf16_t*)(ws + WS_WIN), DM, MTOK, 7168, DM, e);
            Epi<EPI_PLAIN> ev{}; ev.O = (bf16_t*)(ws + WS_VT); ev.ldc = MTOK; ev.cs = nullptr;
            run_gemm(lds, (const bf16_t*)(ws + WS_WIN) + (size_t)7168 * DM, DM, (const bf16_t*)(ws + WS_H), DM, AW, MTOK, DM, ev);
        } else if constexpr (ph == 2) {
            pool_pass((const bf16_t*)(ws + WS_U), (bf16_t*)(ws + WS_P1));
            attn_phase((const bf16_t*)(ws + WS_Q), (const bf16_t*)(ws + WS_K), (const bf16_t*)(ws + WS_VT), (bf16_t*)(ws + WS_AO));
        } else if constexpr (ph == 3) {
            Epi<EPI_GATE1> e{}; e.O = (bf16_t*)(ws + WS_TMP); e.ldc = DM; e.X1 = (const bf16_t*)(ws + WS_GA); e.ldx = DM;
            run_gemm(lds, (const bf16_t*)(ws + WS_AO), AW, (const bf16_t*)(ws + WS_WAB), AW, MTOK, DM, AW, e);
            for (int gi = 0; gi < 4; ++gi) {
                Epi<EPI_PLAIN> eg{}; eg.O = (bf16_t*)(ws + WS_P2) + gi * 256; eg.ldc = PW; eg.cs = p.in[6] + gi * 256;
                run_gemm(lds, (const bf16_t*)(ws + WS_P1) + gi * 256, PW, (const bf16_t*)(ws + WS_WPG) + gi * 256, 1024, MTOK, 256, 256, eg, gi * 64);
            }
        } else if constexpr (ph == 4) {
            Epi<EPI_GATE2> e{}; e.O = (bf16_t*)(ws + WS_MIXED); e.ldc = DM; e.X1 = (const bf16_t*)(ws + WS_GP); e.X2 = (const bf16_t*)(ws + WS_TMP); e.ldx = DM;
            run_gemm(lds, (const bf16_t*)(ws + WS_P2), PW, (const bf16_t*)(ws + WS_WPB), PW, MTOK, DM, PW, e);
        } else if constexpr (ph == 5) {
#if FUSE_OUT
            Epi<EPI_OUTF> e{}; e.ldsp = lds;
            run_gemm_panel(lds, (const bf16_t*)(ws + WS_MIXED), DM, (const bf16_t*)(ws + WS_WOUT), DM, MTOK, DM, DM, e);
#else
            Epi<EPI_PLAIN> e{}; e.O = (bf16_t*)(ws + WS_Y); e.ldc = DM; e.cs = nullptr;
            run_gemm(lds, (const bf16_t*)(ws + WS_MIXED), DM, (const bf16_t*)(ws + WS_WOUT), DM, MTOK, DM, DM, e);
#endif
        } else if constexpr (ph == 6) {
            #if !FUSE_OUT
            row_pass<false, 2, true>((const bf16_t*)(ws + WS_Y), p.in[0], p.in[9], p.out, p.in[10], (bf16_t*)(ws + WS_H));
#endif
        } else if constexpr (ph == 7) {
            Epi<EPI_UP> e{}; e.ldsp = lds; e.O = (bf16_t*)(ws + WS_ACT); e.cs = p.in[12]; e.cb = p.in[13]; e.halo = (float*)(ws + WS_HALO);
            run_gemm(lds, (const bf16_t*)(ws + WS_H), DM, (const bf16_t*)(ws + WS_WUP), DM, MTOK, UPW, DM, e);
        } else if constexpr (ph == 8) {
            conv_fixup((const float*)(ws + WS_HALO), p.in[12], p.in[13], (bf16_t*)(ws + WS_ACT));
        } else if constexpr (ph == 9) {
            Epi<EPI_DOWNF> e{}; e.ldsp = lds; e.O = (bf16_t*)(ws + WS_H); e.ldc = DM; e.X2 = (const bf16_t*)p.out; e.ldx = DM; e.cs = p.in[15];
            e.xch = (float*)(ws + WS_XCH) + 3 * 64 * 8 * 256; e.cnt = (unsigned*)(ws + WS_BAR) + XCNT_WORD0 + 3 * 64 * 64;
            run_gemm_panel(lds, (const bf16_t*)(ws + WS_ACT), DFF, (const bf16_t*)(ws + WS_WDN), DFF, MTOK, DM, DFF, e);
        } else if constexpr (ph == 10) {
        } else if constexpr (ph == 11) {
            Epi<EPI_PLAIN> e{}; e.O = (bf16_t*)(ws + WS_E); e.ldc = DM; e.cs = nullptr;
            run_gemm_panel(lds, (const bf16_t*)(ws + WS_PB), PLE, (const bf16_t*)(ws + WS_WPLE), PLE, MTOK, DM, PLE, e);
            Epi<EPI_PLEF> e2{}; e2.ldsp = lds; e2.X1 = (const bf16_t*)(ws + WS_E); e2.X2 = (const bf16_t*)(ws + WS_H); e2.ldx = DM; e2.cs = p.in[18];
            e2.xch = (float*)(ws + WS_XCH); e2.cnt = (unsigned*)(ws + WS_BAR) + XCNT_WORD0; e2.Of = p.out;
            run_gemm_panel(lds, (const bf16_t*)(ws + WS_H), DM, (const bf16_t*)(ws + WS_WPGATE), DM, MTOK, DM, DM, e2);
        } else if constexpr (ph == 12) {
        }
    }
}


template <int PH> __global__ __launch_bounds__(512, 2) void k_phase(Params p) {
    extern __shared__ __attribute__((aligned(16))) unsigned char shm[];
    run_phase<PH>(p, shm);
}
#if N_LAUNCH_MODE >= 1
#define XB_TMO      128
#define XB_XCNT(j)  (256  + 64 * (j))
#define XB_XSUB(j)  (1280 + 64 * (j))
#define XB_XGEN(j)  (2304 + 64 * (j))
#define XB_TOP      3328
#define XB_TOPGEN   3392
#define XCD_BAR_WORDS 3456
#define XB_SPIN_CAP (1u << 18)
__device__ __forceinline__ unsigned xb_ld(unsigned* p)              { return __hip_atomic_load(p, __ATOMIC_RELAXED, __HIP_MEMORY_SCOPE_AGENT); }
__device__ __forceinline__ unsigned xb_add(unsigned* p, unsigned v) { return __hip_atomic_fetch_add(p, v, __ATOMIC_RELAXED, __HIP_MEMORY_SCOPE_AGENT); }
__device__ __forceinline__ unsigned xb_xcc_id() { return (unsigned)__builtin_amdgcn_s_getreg((3 << 11) | 20) & 0xFu; }
#define XB_SPIN(cond, bar) do { unsigned _sp = 0; while (cond) { __builtin_amdgcn_s_sleep(1); \
    if ((++_sp & 255u) == 0u) { if (xb_ld(&(bar)[XB_TMO])) break; if (_sp > XB_SPIN_CAP) { atomicAdd(&(bar)[XB_TMO], 1u); break; } } } } while (0)
__device__ __forceinline__ void xcd_barrier_complete(unsigned* bar, unsigned x, unsigned& nloc, unsigned& nx) {
    const unsigned G = gridDim.x;
    unsigned sum, cnt, mine, sp = 0u;
    for (;;) {
        sum = 0u; cnt = 0u; mine = 0u;
#pragma unroll
        for (unsigned j = 0; j < 16; ++j) { const unsigned c = xb_ld(&bar[XB_XCNT(j)]); sum += c; cnt += (c > 0u) ? 1u : 0u; mine = (j == x) ? c : mine; }
        if (sum == G) break;
        __builtin_amdgcn_s_sleep(1);
        if ((++sp & 255u) == 0u) { if (xb_ld(&bar[XB_TMO])) break; if (sp > XB_SPIN_CAP) { atomicAdd(&bar[XB_TMO], 1u); break; } }
    }
    nloc = mine > 0u ? mine : 1u; nx = cnt > 0u ? cnt : 1u;
}
__device__ __forceinline__ void xcd_barrier(unsigned* bar, volatile LAS unsigned* st) {
    asm volatile("s_waitcnt vmcnt(0) lgkmcnt(0)" ::: "memory");
    __syncthreads();
    if (tidx() == 0) {
        const unsigned x = xb_xcc_id();
        unsigned nloc = st[0], nx = st[1];
        if (nloc == 0u) { xcd_barrier_complete(bar, x, nloc, nx); st[0] = nloc; st[1] = nx; }
        const unsigned old = xb_add(&bar[XB_XSUB(x)], 1u);
        const unsigned gen = old / nloc;
        if (old + 1u == (gen + 1u) * nloc) {
            __builtin_amdgcn_fence(__ATOMIC_RELEASE, "agent");
            asm volatile("s_waitcnt vmcnt(0)" ::: "memory");
            const unsigned og = xb_add(&bar[XB_TOP], 1u);
            const unsigned tg = og / nx;
            if (og + 1u == (tg + 1u) * nx) xb_add(&bar[XB_TOPGEN], 1u);
            else XB_SPIN(xb_ld(&bar[XB_TOPGEN]) == tg, bar);
            __builtin_amdgcn_fence(__ATOMIC_ACQUIRE, "agent");
            xb_add(&bar[XB_XGEN(x)], 1u);
            asm volatile("s_waitcnt vmcnt(0)" ::: "memory");
        } else {
            XB_SPIN(xb_ld(&bar[XB_XGEN(x)]) == gen, bar);
            __builtin_amdgcn_fence(__ATOMIC_ACQUIRE, "agent");
            asm volatile("s_waitcnt vmcnt(0)" ::: "memory");
        }
    }
    __syncthreads();
}
typedef const __attribute__((address_space(4))) Params* KargPtr;
#if defined(__HIP_DEVICE_COMPILE__)
#define RUNPH(N) do { KargPtr q = pp; asm volatile("" : "+s"(q)); Params pl; __builtin_memcpy(&pl, q, sizeof(Params)); if (N >= pl.ph_lo && N < pl.ph_hi) { run_phase<N>(pl, shm); if (N + 1 < pl.ph_hi) GSYNC(); } } while (0)
#else
#define RUNPH(N) do { } while (0)
#endif
__global__ __launch_bounds__(512, 2) void mega(Params p_unused) {
    extern __shared__ __attribute__((aligned(16))) unsigned char shm[];
    cg::grid_group grid = cg::this_grid();
    KargPtr pp = (KargPtr)__builtin_amdgcn_kernarg_segment_ptr();
    volatile LAS unsigned* xst = (volatile LAS unsigned*)((LAS unsigned char*)shm + STAGE_BYTES);
    if (tidx() == 0) { xst[0] = 0u; xst[1] = 0u; (void)xb_add(&((unsigned*)(pp->ws + WS_BAR))[XB_XCNT(xb_xcc_id())], 1u); }
    __syncthreads();
    if (pp->ph_lo < 0) grid.sync();
#define GSYNC() do { KargPtr qb = pp; asm volatile("" : "+s"(qb)); xcd_barrier((unsigned*)(qb->ws + WS_BAR), xst); } while (0)
    RUNPH(0);
    RUNPH(1);
    RUNPH(2);
    RUNPH(3);
    RUNPH(4);
    RUNPH(5);
#if !FUSE_OUT
    RUNPH(6);
#endif
    RUNPH(7);
    RUNPH(8);
    RUNPH(9);
    RUNPH(11);
}
#endif
template <int PH> static void launch_phase(const Params& p, int grid, hipStream_t stream) {
    (void)hipFuncSetAttribute((const void*)k_phase<PH>, hipFuncAttributeMaxDynamicSharedMemorySize, STAGE_BYTES);
    hipLaunchKernelGGL(k_phase<PH>, dim3(grid), dim3(512), STAGE_BYTES, stream, p);
}
extern "C" void kernel_launch(void* const* d_in, const int* in_sizes, int n_in, void* d_out, int out_size, void* d_ws, size_t ws_size, hipStream_t stream) {
    static int grid = 0;
    if (grid == 0) {
        int dev = 0, cus = 0, per_cu = 0;
        (void)hipGetDevice(&dev);
        (void)hipDeviceGetAttribute(&cus, hipDeviceAttributeMultiprocessorCount, dev);
#if N_LAUNCH_MODE >= 1
        (void)hipFuncSetAttribute((const void*)mega, hipFuncAttributeMaxDynamicSharedMemorySize, LDS_BYTES);
        (void)hipOccupancyMaxActiveBlocksPerMultiprocessor(&per_cu, (const void*)mega, 512, LDS_BYTES);
#endif
        if (per_cu < 1) per_cu = 1;
        grid = cus * per_cu;
        if (grid > 256) grid = 256;
        if (n_in != 19 || ws_size < 484 * MiB) { fprintf(stderr, "kernel_launch: unexpected n_in %d / ws_size %zu\n", n_in, ws_size); }
    }
    Params p{};
    for (int i = 0; i < 19; ++i) p.in[i] = (const float*)d_in[i];
    p.out = (float*)d_out; p.ws = (unsigned char*)d_ws;
    p.ph_lo = 0; p.ph_hi = 12;
#if N_LAUNCH_MODE == 1
    (void)hipMemsetAsync((unsigned char*)d_ws + WS_BAR, 0, 131072, stream);
    void* args[] = {&p};
    hipError_t e = hipLaunchCooperativeKernel((const void*)mega, dim3(grid), dim3(512), args, LDS_BYTES, stream);
    if (e != hipSuccess) fprintf(stderr, "cooperative launch failed: %s (grid %d)\n", hipGetErrorString(e), grid);
#elif N_LAUNCH_MODE == 2
#ifndef BISECT_X
#define BISECT_X 2
#endif
#define LP(N) do { if (N < BISECT_X) launch_phase<N>(p, grid, stream); else { p.ph_lo = N; p.ph_hi = N + 1; hipLaunchKernelGGL(mega, dim3(grid), dim3(512), LDS_BYTES, stream, p); } } while (0)
    LP(0); LP(1); LP(2); LP(3); LP(4); LP(5); LP(6); LP(7); LP(8); LP(9); LP(10); LP(11); LP(12);
#else
    launch_phase<0>(p, grid, stream); launch_phase<1>(p, grid, stream); launch_phase<2>(p, grid, stream); launch_phase<3>(p, grid, stream);
    launch_phase<4>(p, grid, stream); launch_phase<5>(p, grid, stream); launch_phase<6>(p, grid, stream); launch_phase<7>(p, grid, stream);
    launch_phase<8>(p, grid, stream); launch_phase<9>(p, grid, stream); launch_phase<10>(p, grid, stream); launch_phase<11>(p, grid, stream);
    launch_phase<12>(p, grid, stream);
#endif
}
```
